# Optimizing an MI355X kernel written in HIP

```python
import jax, jax.numpy as jnp
from jax import lax
import numpy as np

D_MODEL = 2048
BATCH = 8
SEQ = 2048
DEPTH = 1
DEC_BATCH = 128
DEC_SEQ = 8
PAST_LEN = 8192
PAGE_SIZE = 128

CHUNK = 128
A_WIDTH = 1024
A_GROUPS = 8
A_GROUP_DIM = A_WIDTH // A_GROUPS
HEAD_DIM = 64
N_HEADS = 16
N_KV_HEADS = 4
Q_PER_KV = N_HEADS // N_KV_HEADS
B_WIDTH = N_HEADS * HEAD_DIM
KV_WIDTH = N_KV_HEADS * HEAD_DIM
WINDOW = 128
ROPE_THETA = 10000.0
EPS = 1e-6
IN_COLS = 3 * A_WIDTH + 2 * B_WIDTH + 2 * KV_WIDTH + 2 * D_MODEL

kernel_name = "hybrid_gmlp_swa_sink_decode_step"


def _rmsnorm(x, g):
    xf = x.astype(jnp.float32)
    y = xf * lax.rsqrt(jnp.mean(xf * xf, axis=-1, keepdims=True) + EPS)
    return (y * g.astype(jnp.float32)).astype(x.dtype)


def _layernorm(x, g, b):
    xf = x.astype(jnp.float32)
    mu = jnp.mean(xf, axis=-1, keepdims=True)
    xc = xf - mu
    y = xc * lax.rsqrt(jnp.mean(xc * xc, axis=-1, keepdims=True) + EPS)
    return (y * g.astype(jnp.float32) + b.astype(jnp.float32)).astype(x.dtype)


def _rope(x, pos):
    inv = ROPE_THETA ** (-jnp.arange(0, HEAD_DIM, 2, dtype=jnp.float32) / HEAD_DIM)
    ang = pos.astype(jnp.float32)[:, None] * inv[None, :]
    cos = jnp.cos(ang)[:, None, :]
    sin = jnp.sin(ang)[:, None, :]
    xf = x.astype(jnp.float32)
    x1, x2 = xf[..., : HEAD_DIM // 2], xf[..., HEAD_DIM // 2:]
    out = jnp.concatenate([x1 * cos - x2 * sin, x2 * cos + x1 * sin], axis=-1)
    return out.astype(x.dtype)


def _project_in(x, pos, g_pre, w_in, ln_v_g, ln_v_b):
    bsz, t, _ = x.shape
    z = _rmsnorm(x, g_pre) @ w_in
    sizes = (A_WIDTH, A_WIDTH, A_WIDTH, B_WIDTH, KV_WIDTH, KV_WIDTH, B_WIDTH, D_MODEL, D_MODEL)
    idx = [int(i) for i in np.cumsum(sizes)[:-1]]
    u, v, z_a, q, k, v_att, z_b, gate_a, gate_b = jnp.split(z, idx, axis=-1)
    u = jax.nn.gelu(u, approximate=False)
    v = _layernorm(jax.nn.gelu(v, approximate=False), ln_v_g, ln_v_b)
    q = _rope(q.reshape(bsz, t, N_HEADS, HEAD_DIM), pos)
    k = _rope(k.reshape(bsz, t, N_KV_HEADS, HEAD_DIM), pos)
    v_att = v_att.reshape(bsz, t, N_KV_HEADS, HEAD_DIM)
    return u, v, z_a, q, k, v_att, z_b, gate_a, gate_b


def _spatial_gate_branch(u, v, z_a, w_s, b_s):
    bsz, t, _ = v.shape
    n = -(-t // CHUNK)
    pad = n * CHUNK - t
    vp = jnp.pad(v, ((0, 0), (0, pad), (0, 0))).reshape(bsz, n, CHUNK, A_GROUPS, A_GROUP_DIM)
    mask = jnp.tril(jnp.ones((CHUNK, CHUNK), dtype=bool))
    w = jnp.where(mask[None], w_s, jnp.zeros_like(w_s))
    s = jnp.einsum('gts,bnsgc->bntgc', w, vp) + b_s.T[None, None, :, :, None]
    s = s.reshape(bsz, n * CHUNK, A_WIDTH)[:, :t]
    return (u * s) * jax.nn.silu(z_a)


def _sink_attention(q, k, v, mask, sinks):
    lead = q.shape[:-3]
    tq = q.shape[-3]
    qg = q.reshape(*lead, tq, N_KV_HEADS, Q_PER_KV, HEAD_DIM)
    s = jnp.einsum('...qkgd,...skd->...kgqs', qg, k).astype(jnp.float32) * (HEAD_DIM ** -0.5)
    s = jnp.where(mask[..., None, None, :, :], s, -jnp.inf)
    sink = sinks.astype(jnp.float32).reshape(N_KV_HEADS, Q_PER_KV, 1, 1)
    m = jnp.maximum(jnp.max(s, axis=-1, keepdims=True), sink)
    p = jnp.exp(s - m)
    denom = jnp.sum(p, axis=-1, keepdims=True) + jnp.exp(sink - m)
    p = (p / denom).astype(v.dtype)
    o = jnp.einsum('...kgqs,...skd->...qkgd', p, v)
    return o.reshape(*lead, tq, B_WIDTH)


def _prompt_window_attention(q, k, v, sinks):
    bsz, t = q.shape[:2]
    nb = t // WINDOW

    def blocks(a):
        ab = a.reshape(bsz, nb, WINDOW, N_KV_HEADS, HEAD_DIM)
        prev = jnp.concatenate([jnp.zeros_like(ab[:, :1]), ab[:, :-1]], axis=1)
        return jnp.concatenate([prev, ab], axis=2)

    qb = q.reshape(bsz, nb, WINDOW, N_HEADS, HEAD_DIM)
    qpos = jnp.arange(nb)[:, None] * WINDOW + jnp.arange(WINDOW)[None, :]
    kpos = jnp.arange(nb)[:, None] * WINDOW + jnp.arange(-WINDOW, WINDOW)[None, :]
    d = qpos[:, :, None] - kpos[:, None, :]
    mask = (d >= 0) & (d < WINDOW) & (kpos[:, None, :] >= 0)
    o = _sink_attention(qb, blocks(k), blocks(v), mask, sinks)
    return o.reshape(bsz, t, B_WIDTH)


def _sample_window_attention(q, k, v, cache_k, cache_v, sinks):
    bsz, t = q.shape[:2]
    kk = jnp.concatenate([cache_k, k], axis=1)
    vv = jnp.concatenate([cache_v, v], axis=1)
    qpos = PAST_LEN + jnp.arange(t)
    kpos = PAST_LEN - WINDOW + jnp.arange(WINDOW + t)
    d = qpos[:, None] - kpos[None, :]
    mask = (d >= 0) & (d < WINDOW)
    o = _sink_attention(q, kk, vv, mask, sinks)
    return o, kk[:, -WINDOW:], vv[:, -WINDOW:]


def _merge_out(x, a_out, b_out, gate_a, gate_b, w_proj_a, w_proj_b, w_out, g_post):
    merged = jax.nn.sigmoid(gate_a) * (a_out @ w_proj_a) + jax.nn.sigmoid(gate_b) * (b_out @ w_proj_b)
    return x + _rmsnorm(merged @ w_out, g_post)


def setup_inputs(seed: int = 0) -> dict:
    key = jax.random.key(seed)
    ks = jax.random.split(key, 16)
    f32 = jnp.float32
    nrm = lambda k, shape, scale: jax.random.normal(k, shape, f32) * scale
    return {
        "x_prompt": nrm(ks[0], (BATCH, SEQ, D_MODEL), 1.0),
        "x_sample": nrm(ks[1], (DEC_BATCH, DEC_SEQ, D_MODEL), 1.0),
        "cache_k_win": nrm(ks[2], (DEPTH, DEC_BATCH, WINDOW, N_KV_HEADS, HEAD_DIM), 1.0),
        "cache_v_win": nrm(ks[3], (DEPTH, DEC_BATCH, WINDOW, N_KV_HEADS, HEAD_DIM), 1.0),
        "g_pre": 1.0 + nrm(ks[4], (DEPTH, D_MODEL), 0.02),
        "w_in": nrm(ks[5], (DEPTH, D_MODEL, IN_COLS), D_MODEL ** -0.5),
        "ln_v_g": 1.0 + nrm(ks[6], (DEPTH, A_WIDTH), 0.02),
        "ln_v_b": nrm(ks[7], (DEPTH, A_WIDTH), 0.02),
        "w_spatial": nrm(ks[8], (DEPTH, A_GROUPS, CHUNK, CHUNK), CHUNK ** -0.5),
        "b_spatial": 1.0 + nrm(ks[9], (DEPTH, A_GROUPS, CHUNK), 0.02),
        "sinks": nrm(ks[10], (DEPTH, N_HEADS), 0.5),
        "w_proj_a": nrm(ks[11], (DEPTH, A_WIDTH, D_MODEL), A_WIDTH ** -0.5),
        "w_proj_b": nrm(ks[12], (DEPTH, B_WIDTH, D_MODEL), B_WIDTH ** -0.5),
        "w_out": nrm(ks[13], (DEPTH, D_MODEL, D_MODEL), D_MODEL ** -0.5),
        "g_post": 1.0 + nrm(ks[14], (DEPTH, D_MODEL), 0.02),
    }


def reference(x_prompt, x_sample, cache_k_win, cache_v_win, g_pre, w_in, ln_v_g, ln_v_b,
              w_spatial, b_spatial, sinks, w_proj_a, w_proj_b, w_out, g_post):
    pos_p = jnp.arange(SEQ)
    pos_s = PAST_LEN + jnp.arange(DEC_SEQ)
    xp, xs = x_prompt, x_sample
    kp_l, vp_l, ks_l, vs_l, cv_l = [], [], [], [], []
    for l in range(DEPTH):
        u, v, z_a, q, k, va, z_b, ga, gb = _project_in(xp, pos_p, g_pre[l], w_in[l], ln_v_g[l], ln_v_b[l])
        a_out = _spatial_gate_branch(u, v, z_a, w_spatial[l], b_spatial[l])
        b_out = _prompt_window_attention(q, k, va, sinks[l]) * jax.nn.silu(z_b)
        xp = _merge_out(xp, a_out, b_out, ga, gb, w_proj_a[l], w_proj_b[l], w_out[l], g_post[l])
        kp_l.append(k[:, -WINDOW:])
        vp_l.append(va[:, -WINDOW:])
        u, v, z_a, q, k, va, z_b, ga, gb = _project_in(xs, pos_s, g_pre[l], w_in[l], ln_v_g[l], ln_v_b[l])
        a_out = _spatial_gate_branch(u, v, z_a, w_spatial[l], b_spatial[l])
        o, k_new_win, v_new_win = _sample_window_attention(q, k, va, cache_k_win[l], cache_v_win[l], sinks[l])
        b_out = o * jax.nn.silu(z_b)
        xs = _merge_out(xs, a_out, b_out, ga, gb, w_proj_a[l], w_proj_b[l], w_out[l], g_post[l])
        ks_l.append(k_new_win)
        vs_l.append(v_new_win)
        cv_l.append(v)
    return (xp, xs, jnp.stack(kp_l), jnp.stack(vp_l), jnp.stack(ks_l), jnp.stack(vs_l), jnp.stack(cv_l))
```

```cpp
#include <hip/hip_runtime.h>
#include <hip/hip_cooperative_groups.h>
#include <cstdio>
#include <cstdint>
namespace cg = cooperative_groups;

#ifndef MK_N_LAUNCHES
#define MK_N_LAUNCHES 1
#endif

namespace pg8 {
#define PG8_LAS __attribute__((address_space(3)))
typedef unsigned short bf16_t;
typedef short bf16x8 __attribute__((ext_vector_type(8)));
typedef float f32x4 __attribute__((ext_vector_type(4)));
typedef float f32x2 __attribute__((ext_vector_type(2)));
typedef unsigned u32x4 __attribute__((ext_vector_type(4)));
typedef unsigned u32x2 __attribute__((ext_vector_type(2)));
constexpr int BM = 256, BK = 64, HALF = 128, HTB = HALF * BK * 2  , STAGE_BYTES = 8 * HTB, NXCD = 8, WGM = 8;

__host__ __device__ __forceinline__ int lds_byte(int r, int c) { const int st = (r >> 4) * 2 + (c >> 5), rr = r & 15, cc = c & 31, ob = rr * 64 + cc * 2; return st * 1024 + (ob ^ (((ob >> 9) & 1) << 5)); }
__host__ __device__ __forceinline__ void stage_rc(int b, int& R, int& C) { const int st = b / 1024, sb = b % 1024, swz = sb ^ (((sb >> 9) & 1) << 5); R = (st >> 1) * 16 + swz / 64; C = (st & 1) * 32 + (swz % 64) / 2; }
__host__ __device__ __forceinline__ int perm32(int rho) { const int n = rho >> 4, i = rho & 15; return 8 * (i >> 2) + 4 * n + (i & 3); }

struct Unit { int pm, pn, kh; };
struct Gemm { const bf16_t *A0, *A1, *Bt0, *Bt1; int K; };

struct StaticOrder {
    int nM, nN, nwg, G, c, nkh;
    __device__ void init(int M, int N, int G_, int c_, int nkh_) { nM = M / BM; nN = N / BM; nwg = nM * nN; G = G_; c = c_; nkh = nkh_; }
    __device__ bool next(int i, Unit& u) const {
        const int ti = (nkh == 2) ? (i >> 1) : i; u.kh = (nkh == 2) ? (i & 1) : 0;
        const long L = (long)ti * G + c; if (L >= nwg) return false;
        int wgid = (int)L; { const int q = nwg / NXCD, r = nwg % NXCD, xcd = wgid % NXCD, off = wgid / NXCD; wgid = (xcd < r ? xcd * (q + 1) : r * (q + 1) + (xcd - r) * q) + off; }
        const int nig = WGM * nN, gid = wgid / nig, fm = gid * WGM, gsz = (nM - fm) < WGM ? (nM - fm) : WGM;
        u.pm = fm + ((wgid % nig) % gsz); u.pn = (wgid % nig) / gsz; return true;
    }
    __device__ __forceinline__ void a_ready(const Unit&) const {}
    __device__ __forceinline__ void done(const Unit&) const {}
};

__device__ __forceinline__ unsigned cvt_pk_bf16(float lo, float hi) { unsigned r; asm volatile("v_cvt_pk_bf16_f32 %0, %1, %2" : "=v"(r) : "v"(lo), "v"(hi)); return r; }
__device__ __forceinline__ u32x4 pack8(f32x4 a, f32x4 b) { u32x4 w; w.x = cvt_pk_bf16(a[0], a[1]); w.y = cvt_pk_bf16(a[2], a[3]); w.z = cvt_pk_bf16(b[0], b[1]); w.w = cvt_pk_bf16(b[2], b[3]); return w; }
__device__ __forceinline__ float bf_lo(unsigned w) { return __uint_as_float(w << 16); }
__device__ __forceinline__ float bf_hi(unsigned w) { return __uint_as_float(w & 0xffff0000u); }
__device__ __forceinline__ f32x2 gelu_pk(f32x2 v) {
    const f32x2 av = __builtin_elementwise_abs(v), d = av * 0.2316418882f + 1.0f;
    f32x2 t; t.x = __builtin_amdgcn_rcpf(d.x); t.y = __builtin_amdgcn_rcpf(d.y);
    f32x2 q = t * 0.5307027145f + (-0.7265760135f); q = q * t + 0.7107068705f; q = q * t + (-0.142248368f); q = q * t + 0.127414796f; q = q * t;
    const f32x2 s = (v * v) * (-0.72134752044f);
    f32x2 e; e.x = __builtin_amdgcn_exp2f(s.x); e.y = __builtin_amdgcn_exp2f(s.y);
    const f32x2 m = v * (q * e), r = v - m;
    f32x2 o; o.x = v.x < 0.f ? m.x : r.x; o.y = v.y < 0.f ? m.y : r.y; return o;
}
__device__ __forceinline__ f32x4 gelu4(f32x4 v) { const f32x2 a = gelu_pk((f32x2){v[0], v[1]}), b = gelu_pk((f32x2){v[2], v[3]}); return (f32x4){a.x, a.y, b.x, b.y}; }
__device__ __forceinline__ float sigm(float x) { return __builtin_amdgcn_rcpf(1.0f + __builtin_amdgcn_exp2f(-1.4426950408889634f * x)); }
__device__ __forceinline__ f32x4 sigm4(f32x4 v) { return (f32x4){sigm(v[0]), sigm(v[1]), sigm(v[2]), sigm(v[3])}; }
__device__ __forceinline__ f32x4 silu4(f32x4 v) { return v * sigm4(v); }

template <class Epi, class Sched, bool ALIGN_EPI = false, bool SP2 = false>
__device__ __forceinline__ void gemm_phase(PG8_LAS unsigned char* lds, const Gemm g, const Sched& S, const Epi& E) {
    const int tid = threadIdx.x, wid = __builtin_amdgcn_readfirstlane(tid >> 6), lane = tid & 63, wr = wid >> 2, wc = wid & 3, fr = lane & 15, fq = lane >> 4;
    const int K = g.K, nt = K / BK; constexpr int lda = 2048, ldb = 2048;
    unsigned voffA[2], voffB[2];
#pragma unroll
    for (int i = 0; i < 2; ++i) { int R, C; stage_rc(tid * 16 + i * 8192, R, C); const int Rb = Epi::PERM ? ((R & ~31) + perm32(R & 31)) : R;
        voffA[i] = (unsigned)(R * lda + C) * 2u; voffB[i] = (unsigned)(Rb * ldb + C) * 2u; }
    const size_t kstep = (size_t)(BK * 2);
    const size_t hstepA = (size_t)HALF * lda * 2, hstepB = (size_t)HALF * ldb * 2;
    const size_t tstepA = 2 * hstepA, tstepB = 2 * hstepB;
    const unsigned ldsw = (unsigned)wid * 1024u;
    const int aoff = lds_byte(wr * 64 + fr, fq * 8), boff = lds_byte(wc * 32 + fr, fq * 8);
#define PG8_SA(b, h) (((b) * 2 + (h)) * HTB)
#define PG8_SB(b, h) ((4 + (b) * 2 + (h)) * HTB)
#define PG8_STAGE(bufoff, gbase, voff) do { _Pragma("unroll") for (int _i = 0; _i < 2; ++_i) \
        __builtin_amdgcn_global_load_lds((const unsigned*)((const char*)(gbase) + (voff)[_i]), (PG8_LAS unsigned*)(lds + (bufoff) + ldsw + _i * 8192), 16, 0, 0); } while (0)
#define PG8_LDA(dst, b, h) do { _Pragma("unroll") for (int m = 0; m < 4; ++m) _Pragma("unroll") for (int k = 0; k < 2; ++k) dst[m][k] = *(const PG8_LAS bf16x8*)(lds + PG8_SA(b, h) + aoff + m * 2048 + k * 1024); } while (0)
#define PG8_LDB(dst, b, h) do { _Pragma("unroll") for (int n = 0; n < 2; ++n) _Pragma("unroll") for (int k = 0; k < 2; ++k) dst[n][k] = *(const PG8_LAS bf16x8*)(lds + PG8_SB(b, h) + boff + n * 2048 + k * 1024); } while (0)
#define PG8_MMA(ai, bj, At, Bt) do { __builtin_amdgcn_s_setprio(1); _Pragma("unroll") for (int m = 0; m < 4; ++m) _Pragma("unroll") for (int n = 0; n < 2; ++n) _Pragma("unroll") for (int k = 0; k < 2; ++k) \
        acc[ai][bj][m][n] = __builtin_amdgcn_mfma_f32_16x16x32_bf16(Bt[n][k], At[m][k], acc[ai][bj][m][n], 0, 0, 0); __builtin_amdgcn_s_setprio(0); } while (0)
#define PG8_WAIT_V(n) asm volatile("s_waitcnt vmcnt(" #n ")" ::: "memory")
#define PG8_WAIT_L(n) asm volatile("s_waitcnt lgkmcnt(" #n ")" ::: "memory")
#define PG8_BAR __builtin_amdgcn_s_barrier()
#define PG8_SCHED __builtin_amdgcn_sched_barrier(0)
    Unit cur, nxt; int ui = 0;
    if (!S.next(0, cur)) return;
    f32x4 acc[2][2][4][2];
#pragma unroll
    for (int a = 0; a < 2; ++a)
#pragma unroll
        for (int b = 0; b < 2; ++b)
#pragma unroll
            for (int m = 0; m < 4; ++m)
#pragma unroll
                for (int n = 0; n < 2; ++n) acc[a][b][m][n] = (f32x4){0.f, 0.f, 0.f, 0.f};
    bf16x8 At[4][2], B0[2][2], B1[2][2];
    const char* cA = (const char*)(cur.kh ? g.A1 : g.A0) + (size_t)cur.pm * tstepA; const char* cB = (const char*)(cur.kh ? g.Bt1 : g.Bt0) + (size_t)cur.pn * tstepB;
    S.a_ready(cur);
    if constexpr (SP2) {
        PG8_STAGE(PG8_SB(0, 0), cB, voffB); PG8_STAGE(PG8_SB(0, 1), cB + hstepB, voffB); PG8_STAGE(PG8_SA(0, 0), cA, voffA); PG8_STAGE(PG8_SA(0, 1), cA + hstepA, voffA);
        if (wr == 1) PG8_BAR;
        PG8_WAIT_V(2); PG8_BAR;
        PG8_STAGE(PG8_SB(1, 0), cB + kstep, voffB); PG8_STAGE(PG8_SA(1, 0), cA + kstep, voffA); PG8_STAGE(PG8_SB(1, 1), cB + hstepB + kstep, voffB);
        PG8_WAIT_V(6); PG8_BAR;
    } else {
        PG8_STAGE(PG8_SB(0, 0), cB, voffB); PG8_STAGE(PG8_SA(0, 0), cA, voffA); PG8_STAGE(PG8_SB(0, 1), cB + hstepB, voffB); PG8_STAGE(PG8_SA(0, 1), cA + hstepA, voffA);
        if (wr == 1) PG8_BAR;
        PG8_WAIT_V(4); PG8_BAR;
        PG8_STAGE(PG8_SB(1, 0), cB + kstep, voffB); PG8_STAGE(PG8_SA(1, 0), cA + kstep, voffA); PG8_STAGE(PG8_SB(1, 1), cB + hstepB + kstep, voffB);
        PG8_WAIT_V(6); PG8_BAR;
    }
    for (;;) {
        const bool has_next = S.next(ui + 1, nxt);
        const char* nA = has_next ? (const char*)(nxt.kh ? g.A1 : g.A0) + (size_t)nxt.pm * tstepA : cA; const char* nB = has_next ? (const char*)(nxt.kh ? g.Bt1 : g.Bt0) + (size_t)nxt.pn * tstepB : cB;
        for (int t = 0; t < nt; t += 2) {
            const bool last = (t == nt - 2);
            const char* a1 = cA + (size_t)(t + 1) * kstep;
            const char* a2 = last ? nA : cA + (size_t)(t + 2) * kstep; const char* b2 = last ? nB : cB + (size_t)(t + 2) * kstep;
            const char* a3 = a2 + kstep; const char* b3 = b2 + kstep;
            if (last && has_next) S.a_ready(nxt);
            if constexpr (SP2) {
            PG8_LDB(B0, 0, 0); PG8_LDB(B1, 0, 1); PG8_SCHED; PG8_LDA(At, 0, 0); PG8_STAGE(PG8_SA(1, 1), a1 + hstepA, voffA);
            PG8_WAIT_V(8); PG8_WAIT_L(0); PG8_BAR; PG8_MMA(0, 0, At, B0); PG8_MMA(0, 1, At, B1); PG8_BAR; PG8_SCHED;
            PG8_LDA(At, 0, 1); PG8_STAGE(PG8_SB(0, 0), b2, voffB); PG8_STAGE(PG8_SB(0, 1), b2 + hstepB, voffB); PG8_STAGE(PG8_SA(0, 0), a2, voffA);
            PG8_WAIT_V(8); PG8_WAIT_L(0); PG8_BAR; PG8_MMA(1, 0, At, B0); PG8_MMA(1, 1, At, B1); PG8_BAR; PG8_SCHED;
            PG8_LDB(B0, 1, 0); PG8_LDB(B1, 1, 1); PG8_SCHED; PG8_LDA(At, 1, 0); PG8_STAGE(PG8_SA(0, 1), a2 + hstepA, voffA);
            PG8_WAIT_V(8); PG8_WAIT_L(0); PG8_BAR; PG8_MMA(0, 0, At, B0); PG8_MMA(0, 1, At, B1); PG8_BAR; PG8_SCHED;
            PG8_LDA(At, 1, 1); PG8_STAGE(PG8_SB(1, 0), b3, voffB); PG8_STAGE(PG8_SB(1, 1), b3 + hstepB, voffB); PG8_STAGE(PG8_SA(1, 0), a3, voffA);
            PG8_WAIT_V(8); PG8_WAIT_L(0); PG8_BAR; PG8_MMA(1, 0, At, B0); PG8_MMA(1, 1, At, B1); PG8_BAR; PG8_SCHED;
            } else {
            PG8_LDB(B0, 0, 0); PG8_SCHED; PG8_LDA(At, 0, 0); PG8_STAGE(PG8_SA(1, 1), a1 + hstepA, voffA);
            PG8_WAIT_L(8); PG8_BAR; PG8_WAIT_L(0); PG8_MMA(0, 0, At, B0); PG8_BAR; PG8_SCHED;
            PG8_LDB(B1, 0, 1); PG8_STAGE(PG8_SB(0, 0), b2, voffB);
            PG8_BAR; PG8_WAIT_L(0); PG8_MMA(0, 1, At, B1); PG8_BAR;
            PG8_LDA(At, 0, 1); PG8_STAGE(PG8_SA(0, 0), a2, voffA);
            PG8_BAR; PG8_WAIT_L(0); PG8_MMA(1, 0, At, B0); PG8_BAR; PG8_SCHED;
            PG8_STAGE(PG8_SB(0, 1), b2 + hstepB, voffB);
            PG8_WAIT_V(6); PG8_BAR; PG8_MMA(1, 1, At, B1); PG8_BAR;
            PG8_LDB(B0, 1, 0); PG8_SCHED; PG8_LDA(At, 1, 0); PG8_STAGE(PG8_SA(0, 1), a2 + hstepA, voffA);
            PG8_WAIT_L(8); PG8_BAR; PG8_WAIT_L(0); PG8_MMA(0, 0, At, B0); PG8_BAR; PG8_SCHED;
            PG8_LDB(B1, 1, 1); PG8_STAGE(PG8_SB(1, 0), b3, voffB);
            PG8_BAR; PG8_WAIT_L(0); PG8_MMA(0, 1, At, B1); PG8_BAR;
            PG8_LDA(At, 1, 1); PG8_STAGE(PG8_SA(1, 0), a3, voffA);
            PG8_BAR; PG8_WAIT_L(0); PG8_MMA(1, 0, At, B0); PG8_BAR; PG8_SCHED;
            PG8_STAGE(PG8_SB(1, 1), b3 + hstepB, voffB);
            PG8_WAIT_V(6); PG8_BAR; PG8_MMA(1, 1, At, B1); PG8_BAR;
            }
        }
        if constexpr (ALIGN_EPI) { if (wr == 0) PG8_BAR; }
        if constexpr (!Epi::AFTER_DRAIN) { E(acc, cur, wr, wc, fr, fq); S.done(cur); }
        if (!has_next) break;
        if (cur.kh == Epi::NKH - 1) {
#pragma unroll
        for (int a = 0; a < 2; ++a)
#pragma unroll
            for (int b = 0; b < 2; ++b)
#pragma unroll
                for (int m = 0; m < 4; ++m)
#pragma unroll
                    for (int n = 0; n < 2; ++n) acc[a][b][m][n] = (f32x4){0.f, 0.f, 0.f, 0.f};
        }
        cur = nxt; cA = nA; cB = nB; ++ui;
        if constexpr (ALIGN_EPI) { if (wr == 1) PG8_BAR; }
    }
    PG8_WAIT_V(0);
    if constexpr (!ALIGN_EPI) { if (wr == 0) PG8_BAR; }
    PG8_BAR;
    if constexpr (Epi::AFTER_DRAIN) { E.fused(acc, cur, wr, wc, fr, fq, lds, wid, lane); S.done(cur); }
#undef PG8_SA
#undef PG8_SB
#undef PG8_STAGE
#undef PG8_LDA
#undef PG8_LDB
#undef PG8_MMA
#undef PG8_WAIT_V
#undef PG8_WAIT_L
#undef PG8_BAR
#undef PG8_SCHED
}}

using pg8::bf16_t; using pg8::bf16x8; using pg8::f32x4; using pg8::f32x2; using pg8::u32x4; using pg8::u32x2; using pg8::Unit;
#define LAS __attribute__((address_space(3)))
typedef short s16x4 __attribute__((ext_vector_type(4)));

constexpr int NWAVES = 8, NTHR = 512;
constexpr int DM = 2048, NB = 8, SEQ = 2048, DB = 128, DS = 8, PAST = 8192;
constexpr int MP = NB * SEQ, MS = DB * DS, M = MP + MS;
constexpr int AW = 1024, NG = 8, CH = 128, HD = 64, NH = 16, NKV = 4, BW = 1024, KVW = 256, WIN = 128;
constexpr int INC = 3 * AW + 2 * BW + 2 * KVW + 2 * DM;
constexpr int Z1W = 5632, GW = 4096;
constexpr int C_U = 0, C_V = 1024, C_ZA = 2048, C_Q = 3072, C_K = 4096, C_VA = 4352, C_ZB = 4608;
constexpr float EPS = 1e-6f;
constexpr float QSCALE = 0.125f * 1.4426950408889634f;
constexpr float LOG2E = 1.4426950408889634f;
constexpr int NTPOS = SEQ + DS;

constexpr size_t O_Y = 0, O_KWP = (size_t)M * DM, O_VWP = O_KWP + (size_t)NB * WIN * KVW, O_KWS = O_VWP + (size_t)NB * WIN * KVW,
                 O_VWS = O_KWS + (size_t)DB * WIN * KVW, O_CV = O_VWS + (size_t)DB * WIN * KVW, O_END = O_CV + (size_t)MS * AW;

constexpr size_t al256(size_t x) { return (x + 255) & ~(size_t)255; }
constexpr size_t WS_ROPE = 0;
constexpr size_t WS_STATS = al256(WS_ROPE + (size_t)NTPOS * 32 * 2 * 4);
constexpr size_t WS_SSQ = al256(WS_STATS + (size_t)M * 32 * 4);
constexpr size_t WS_WIN = al256(WS_SSQ + (size_t)M * 32 * 4);
constexpr size_t WS_WP = al256(WS_WIN + (size_t)INC * DM * 2);
constexpr size_t WS_WOUT = al256(WS_WP + (size_t)DM * 2048 * 2);
constexpr size_t WS_H = al256(WS_WOUT + (size_t)DM * DM * 2);
constexpr size_t WS_Z1 = al256(WS_H + (size_t)M * DM * 2);
constexpr size_t WS_G = al256(WS_Z1 + (size_t)M * Z1W * 2);
constexpr size_t WS_END = al256(WS_G + (size_t)M * GW * 2);

constexpr int LDS_BYTES = 139264;

enum { T_U = 0, T_V, T_ZA, T_Q, T_K, T_VA, T_ZB, T_G };
struct EpiIn {
    static constexpr bool PERM = true, AFTER_DRAIN = false; static constexpr int NKH = 1;
    bf16_t* Z1; bf16_t* G; float* stats; const float* rope; float* out;
    template <int TY> __device__ __forceinline__ void tile(f32x4 (&acc)[2][2][4][2], const Unit& u, int wr, int wc, int fr, int fq) const {
        const int cl = wc * 32 + 8 * fq; const int i0 = (16 * wc + 4 * fq) & 31;
#pragma unroll
        for (int ai = 0; ai < 2; ++ai)
#pragma unroll
            for (int m = 0; m < 4; ++m) {
                const int row = u.pm * 256 + ai * 128 + wr * 64 + m * 16 + fr;
                f32x4 rc0 = {0.f, 0.f, 0.f, 0.f}, rc1 = {0.f, 0.f, 0.f, 0.f};
                if (TY == T_Q || TY == T_K) {
                    const int tpos = row < MP ? (row & (SEQ - 1)) : SEQ + ((row - MP) & (DS - 1));
                    const f32x4* rp = (const f32x4*)(rope + ((size_t)tpos * 32 + i0) * 2); rc0 = rp[0]; rc1 = rp[1];
                }
                float ss = 0.f, sq = 0.f;
                bool win = false; size_t wbase = 0; float* wk = nullptr;
                if (TY == T_K || TY == T_VA) {
                    if (row < MP) { const int t = row & (SEQ - 1); win = t >= SEQ - WIN; wbase = ((size_t)(row >> 11) * WIN + (t - (SEQ - WIN))) * KVW; wk = out + (TY == T_K ? O_KWP : O_VWP); }
                    else { const int r = row - MP; win = true; wbase = ((size_t)(r >> 3) * WIN + (WIN - DS) + (r & 7)) * KVW; wk = out + (TY == T_K ? O_KWS : O_VWS); }
                }
#pragma unroll
                for (int bj = 0; bj < 2; ++bj) {
                    f32x4 a = acc[ai][bj][m][0], b = acc[ai][bj][m][1];
                    const int col = u.pn * 256 + bj * 128 + cl;
                    if (TY == T_U || TY == T_V) { a = pg8::gelu4(a); b = pg8::gelu4(b); }
                    if (TY == T_V) { ss += (a[0] + a[1]) + (a[2] + a[3]) + (b[0] + b[1]) + (b[2] + b[3]);
                        sq += (a[0] * a[0] + a[1] * a[1]) + (a[2] * a[2] + a[3] * a[3]) + (b[0] * b[0] + b[1] * b[1]) + (b[2] * b[2] + b[3] * b[3]); }
                    if (TY == T_ZA || TY == T_ZB) { a = pg8::silu4(a); b = pg8::silu4(b); }
                    if (TY == T_G) { a = pg8::sigm4(a); b = pg8::sigm4(b); }
                    if (TY == T_Q || TY == T_K) {
                        f32x4 ra, rb;
                        ra[0] = a[0] * rc0[0] - a[1] * rc0[1]; ra[1] = a[1] * rc0[0] + a[0] * rc0[1];
                        ra[2] = a[2] * rc0[2] - a[3] * rc0[3]; ra[3] = a[3] * rc0[2] + a[2] * rc0[3];
                        rb[0] = b[0] * rc1[0] - b[1] * rc1[1]; rb[1] = b[1] * rc1[0] + b[0] * rc1[1];
                        rb[2] = b[2] * rc1[2] - b[3] * rc1[3]; rb[3] = b[3] * rc1[2] + b[2] * rc1[3];
                        a = ra; b = rb;
                        if (TY == T_Q) { a = a * QSCALE; b = b * QSCALE; }
                    }
                    if (TY == T_K) { if (win) { float* o = wk + wbase + (bj * 2 + (wc >> 1)) * HD + i0;
                        *(f32x4*)o = (f32x4){a[0], a[2], b[0], b[2]}; *(f32x4*)(o + 32) = (f32x4){a[1], a[3], b[1], b[3]}; } }
                    if (TY == T_VA) { if (win) { float* o = wk + wbase + (bj * 2 + (wc >> 1)) * HD + (cl & 63); *(f32x4*)o = a; *(f32x4*)(o + 4) = b; } }
                    const u32x4 w = pg8::pack8(a, b);
                    if (TY == T_G) *(u32x4*)(G + (size_t)row * GW + (col - Z1W)) = w;
                    else *(u32x4*)(Z1 + (size_t)row * Z1W + col) = w;
                }
                if (TY == T_V) {
                    ss += __shfl_xor(ss, 16); ss += __shfl_xor(ss, 32); sq += __shfl_xor(sq, 16); sq += __shfl_xor(sq, 32);
                    if (fq == 0) *(f32x2*)(stats + ((size_t)row * 16 + (u.pn - 4) * 4 + wc) * 2) = (f32x2){ss, sq};
                }
            }
    }
    __device__ __forceinline__ void operator()(f32x4 (&acc)[2][2][4][2], const Unit& u, int wr, int wc, int fr, int fq) const {
        asm volatile("" : "+v"(fr), "+v"(fq));
        const int pn = u.pn;
        if (pn < 4) tile<T_U>(acc, u, wr, wc, fr, fq);
        else if (pn < 8) tile<T_V>(acc, u, wr, wc, fr, fq);
        else if (pn < 12) tile<T_ZA>(acc, u, wr, wc, fr, fq);
        else if (pn < 16) tile<T_Q>(acc, u, wr, wc, fr, fq);
        else if (pn == 16) tile<T_K>(acc, u, wr, wc, fr, fq);
        else if (pn == 17) tile<T_VA>(acc, u, wr, wc, fr, fq);
        else if (pn < 22) tile<T_ZB>(acc, u, wr, wc, fr, fq);
        else tile<T_G>(acc, u, wr, wc, fr, fq);
    }
};
__device__ __forceinline__ void unpack8(u32x4 w, f32x4& a, f32x4& b) {
    a = (f32x4){pg8::bf_lo(w.x), pg8::bf_hi(w.x), pg8::bf_lo(w.y), pg8::bf_hi(w.y)}; b = (f32x4){pg8::bf_lo(w.z), pg8::bf_hi(w.z), pg8::bf_lo(w.w), pg8::bf_hi(w.w)};
}
struct EpiMerge {
    static constexpr bool PERM = true, AFTER_DRAIN = false; static constexpr int NKH = 2;
    const bf16_t* G; bf16_t* MG;
    __device__ __forceinline__ void operator()(f32x4 (&acc)[2][2][4][2], const Unit& u, int wr, int wc, int fr, int fq) const {
        asm volatile("" : "+v"(fr), "+v"(fq));
        const int cl = wc * 32 + 8 * fq;
#pragma unroll
        for (int ai = 0; ai < 2; ++ai)
#pragma unroll
            for (int m = 0; m < 4; ++m) {
                const int row = u.pm * 256 + ai * 128 + wr * 64 + m * 16 + fr;
#pragma unroll
                for (int bj = 0; bj < 2; ++bj) {
                    const int col = u.pn * 256 + bj * 128 + cl;
                    f32x4 sb0, sb1; unpack8(*(const u32x4*)(G + (size_t)row * GW + DM + col), sb0, sb1);
                    if (u.kh == 0) {
                        f32x4 sa0, sa1; unpack8(*(const u32x4*)(G + (size_t)row * GW + col), sa0, sa1);
#pragma unroll
                        for (int j = 0; j < 4; ++j) { acc[ai][bj][m][0][j] *= sa0[j] * __builtin_amdgcn_rcpf(sb0[j]); acc[ai][bj][m][1][j] *= sa1[j] * __builtin_amdgcn_rcpf(sb1[j]); }
                    } else {
                        *(u32x4*)(MG + (size_t)row * DM + col) = pg8::pack8(acc[ai][bj][m][0] * sb0, acc[ai][bj][m][1] * sb1);
                    }
                }
            }
    }
};
struct EpiOut {
    static constexpr bool PERM = true, AFTER_DRAIN = false; static constexpr int NKH = 1;
    float* Y; float* ssq;
    __device__ __forceinline__ void operator()(f32x4 (&acc)[2][2][4][2], const Unit& u, int wr, int wc, int fr, int fq) const {
        asm volatile("" : "+v"(fr), "+v"(fq));
        const int cl = wc * 32 + 8 * fq;
#pragma unroll
        for (int ai = 0; ai < 2; ++ai)
#pragma unroll
            for (int m = 0; m < 4; ++m) {
                const int row = u.pm * 256 + ai * 128 + wr * 64 + m * 16 + fr;
                float sq = 0.f;
#pragma unroll
                for (int bj = 0; bj < 2; ++bj) {
                    const f32x4 a = acc[ai][bj][m][0], b = acc[ai][bj][m][1];
                    float* o = Y + (size_t)row * DM + u.pn * 256 + bj * 128 + cl;
                    *(f32x4*)o = a; *(f32x4*)(o + 4) = b;
                    sq += (a[0] * a[0] + a[1] * a[1]) + (a[2] * a[2] + a[3] * a[3]) + (b[0] * b[0] + b[1] * b[1]) + (b[2] * b[2] + b[3] * b[3]);
                }
                sq += __shfl_xor(sq, 16); sq += __shfl_xor(sq, 32);
                if (fq == 0) ssq[(size_t)row * 32 + u.pn * 4 + wc] = sq;
            }
    }
};
__device__ __forceinline__ float wave_sum(float v) {
#pragma unroll
    for (int o = 1; o < 64; o <<= 1) v += __shfl_xor(v, o);
    return v;
}
__device__ __forceinline__ unsigned f2bf(float f) { unsigned u = __float_as_uint(f); return (u + 0x7fffu + ((u >> 16) & 1u)) >> 16; }
__device__ __forceinline__ unsigned pk2(float lo, float hi) { return pg8::cvt_pk_bf16(lo, hi); }
#define LDS_WAIT() asm volatile("s_waitcnt lgkmcnt(0)" ::: "memory")

struct Ptrs {
    const float *xp, *xs, *ck, *cv, *g_pre, *w_in, *ln_g, *ln_b, *w_sp, *b_sp, *sinks, *w_pa, *w_pb, *w_out, *g_post;
    float* out; unsigned char* ws;
};
static __device__ const double kInvFreq[32] = {1.0, 0.7498942093324559, 0.5623413251903491, 0.4216965034285822, 0.31622776601683794, 0.23713737056616552, 0.1778279410038923, 0.1333521432163324, 0.1, 0.07498942093324558, 0.05623413251903491, 0.042169650342858224, 0.03162277660168379, 0.023713737056616554, 0.01778279410038923, 0.01333521432163324, 0.01, 0.007498942093324558, 0.005623413251903491, 0.004216965034285823, 0.0031622776601683794, 0.0023713737056616554, 0.0017782794100389228, 0.001333521432163324, 0.001, 0.0007498942093324559, 0.0005623413251903491, 0.00042169650342858224, 0.00031622776601683794, 0.00023713737056616554, 0.00017782794100389227, 0.0001333521432163324};

template <bool QKPERM>
__device__ __forceinline__ void p0_transpose_item(const float* W, int N, bf16_t* WT, int ldt, int koff, LAS float* scr, int item, int lane) {
    const int nblk = N / 32, kb = item / nblk, nb = item % nblk, k0 = 64 * kb, n0 = 32 * nb;
#pragma unroll 8
    for (int i = 0; i < 32; ++i) { const int kk = 2 * i + (lane >> 5); scr[kk * 33 + (lane & 31)] = W[(size_t)(k0 + kk) * N + n0 + (lane & 31)]; }
    LDS_WAIT(); asm volatile("" ::: "memory");
    const int c = lane & 7;
#pragma unroll
    for (int j = 0; j < 4; ++j) { const int n = (lane >> 3) + 8 * j; const LAS float* s = scr + (8 * c) * 33 + n;
        u32x4 o; o.x = pk2(s[0 * 33], s[1 * 33]); o.y = pk2(s[2 * 33], s[3 * 33]); o.z = pk2(s[4 * 33], s[5 * 33]); o.w = pk2(s[6 * 33], s[7 * 33]);
        int nn = n0 + n;
        if (QKPERM) { if (nn >= C_Q && nn < C_VA) { const int d = nn & 63; nn = (nn & ~63) + 2 * (d & 31) + (d >> 5); } }
        *(u32x4*)(WT + (size_t)nn * ldt + koff + k0 + 8 * c) = o; }
    LDS_WAIT(); asm volatile("" ::: "memory");
}
__device__ __forceinline__ void p0_prologue(const Ptrs& P, LAS unsigned char* lds, int vcu, int G, int wave, int lane, int tid) {
    LAS float* scr = (LAS float*)(lds + wave * 16384);
    const int gw = vcu * NWAVES + wave, NGW = G * NWAVES;
    bf16_t* WinT = (bf16_t*)(P.ws + WS_WIN); bf16_t* WpT = (bf16_t*)(P.ws + WS_WP); bf16_t* WoutT = (bf16_t*)(P.ws + WS_WOUT);
    constexpr int I_IN = (DM / 64) * (INC / 32), I_PA = (AW / 64) * (DM / 32), I_PB = (BW / 64) * (DM / 32), I_OUT = (DM / 64) * (DM / 32);
    constexpr int NITEMS = I_IN + I_PA + I_PB + I_OUT;
    for (int it = gw; it < NITEMS; it += NGW) {
        int r = it;
        if (r < I_IN) { p0_transpose_item<true>(P.w_in, INC, WinT, DM, 0, scr, r, lane); continue; } r -= I_IN;
        if (r < I_PA) { p0_transpose_item<false>(P.w_pa, DM, WpT, 2048, 0, scr, r, lane); continue; } r -= I_PA;
        if (r < I_PB) { p0_transpose_item<false>(P.w_pb, DM, WpT, 2048, 1024, scr, r, lane); continue; } r -= I_PB;
        p0_transpose_item<false>(P.w_out, DM, WoutT, DM, 0, scr, r, lane);
    }
    bf16_t* H = (bf16_t*)(P.ws + WS_H);
    for (int m = gw; m < M; m += NGW) {
        const float* xrow = m < MP ? P.xp + (size_t)m * DM : P.xs + (size_t)(m - MP) * DM;
        const f32x4* xr = (const f32x4*)xrow + lane; f32x4 v[8]; float s = 0.f;
#pragma unroll
        for (int j = 0; j < 8; ++j) { v[j] = xr[64 * j]; s += (v[j][0] * v[j][0] + v[j][1] * v[j][1]) + (v[j][2] * v[j][2] + v[j][3] * v[j][3]); }
        const float rstd = 1.0f / sqrtf(wave_sum(s) * (1.0f / DM) + EPS);
        u32x2* o = (u32x2*)(H + (size_t)m * DM) + lane;
#pragma unroll
        for (int j = 0; j < 8; ++j) { const f32x4 g = ((const f32x4*)P.g_pre)[lane + 64 * j]; const f32x4 y = v[j] * rstd * g; u32x2 w; w.x = pk2(y[0], y[1]); w.y = pk2(y[2], y[3]); o[64 * j] = w; }
    }
    float* rope = (float*)(P.ws + WS_ROPE);
    const int gt = vcu * NTHR + tid, NGT = G * NTHR;
    for (int e = gt; e < NTPOS * 32; e += NGT) {
        const int tp = e >> 5, i = e & 31; const int pos = tp < SEQ ? tp : PAST + (tp - SEQ);
        const double a = (double)pos * kInvFreq[i]; const double k = __builtin_rint(a * 0.15915494309189535); const float r = (float)(a - k * 6.283185307179586);
        *(f32x2*)(rope + (size_t)e * 2) = (f32x2){__cosf(r), __sinf(r)};
    }
    constexpr int NV = DB * (WIN - DS) * (KVW / 4);
    for (int e = gt; e < 2 * NV; e += NGT) {
        const int which = e >= NV; const int r = which ? e - NV : e; const int db = r / ((WIN - DS) * (KVW / 4)), q = r % ((WIN - DS) * (KVW / 4));
        const f32x4* src = (const f32x4*)(which ? P.cv : P.ck) + (size_t)db * WIN * (KVW / 4) + DS * (KVW / 4) + q;
        f32x4* dst = (f32x4*)(P.out + (which ? O_VWS : O_KWS)) + (size_t)db * WIN * (KVW / 4) + q;
        *dst = *src;
    }
}

constexpr int KS_STRIDE = 72, VT_STRIDE = 264;
constexpr int A_STRIDE = 136;
template <int NKT, int MODE>
__device__ __forceinline__ void attn_qtile(const bf16_t* qp, LAS const unsigned char* Ks, LAS const unsigned char* VTs, int lane, int qt, bool first, float sink2,
                                           bf16_t* op, const bf16_t* zp) {
    const int n = lane & 15, quad = lane >> 4;
    const bf16x8 qf0 = *(const bf16x8*)(qp + quad * 8), qf1 = *(const bf16x8*)(qp + 32 + quad * 8);
    f32x4 s[NKT];
    const int qi = (MODE == 0) ? qt * 16 + n : (n & 7);
#pragma unroll
    for (int kt = 0; kt < NKT; ++kt) {
        bool need;
        if (MODE == 0) need = (kt < 8) ? (!first && kt >= qt) : (kt - 8 <= qt); else need = kt < 9;
        s[kt] = (f32x4){-1e30f, -1e30f, -1e30f, -1e30f};
        if (need) {
            const LAS unsigned char* kp = Ks + (kt * 16 + n) * (KS_STRIDE * 2) + quad * 16;
            const bf16x8 k0 = *(const LAS bf16x8*)kp, k1 = *(const LAS bf16x8*)(kp + 64);
            f32x4 c = {0.f, 0.f, 0.f, 0.f};
            c = __builtin_amdgcn_mfma_f32_16x16x32_bf16(k0, qf0, c, 0, 0, 0);
            c = __builtin_amdgcn_mfma_f32_16x16x32_bf16(k1, qf1, c, 0, 0, 0);
#pragma unroll
            for (int j = 0; j < 4; ++j) { const int kk = kt * 16 + quad * 4 + j; bool vis;
                if (MODE == 0) vis = (kk < 128) ? (kk > qi) : (kk - 128 <= qi); else vis = (kk < 128) ? (kk > qi) : (kk - 128 <= qi);
                s[kt][j] = vis ? c[j] : -1e30f; }
        }
    }
    float mx = -1e30f;
#pragma unroll
    for (int kt = 0; kt < NKT; ++kt) mx = fmaxf(mx, fmaxf(fmaxf(s[kt][0], s[kt][1]), fmaxf(s[kt][2], s[kt][3])));
    mx = fmaxf(mx, __shfl_xor(mx, 16)); mx = fmaxf(mx, __shfl_xor(mx, 32)); mx = fmaxf(mx, sink2);
    float sum = 0.f;
#pragma unroll
    for (int kt = 0; kt < NKT; ++kt) {
#pragma unroll
        for (int j = 0; j < 4; ++j) { const float p = __builtin_amdgcn_exp2f(s[kt][j] - mx); s[kt][j] = p; sum += p; } }
    sum += __shfl_xor(sum, 16); sum += __shfl_xor(sum, 32); sum += __builtin_amdgcn_exp2f(sink2 - mx);
    const float inv = 1.0f / sum;
    f32x4 o[4];
#pragma unroll
    for (int dt = 0; dt < 4; ++dt) o[dt] = (f32x4){0.f, 0.f, 0.f, 0.f};
#pragma unroll
    for (int pp = 0; pp < NKT / 2; ++pp) {
        bool need;
        if (MODE == 0) need = (pp < 4) ? (!first && 2 * pp + 1 >= qt) : (2 * pp - 8 <= qt); else need = pp < 5;
        if (need) {
            u32x4 pw; pw.x = pk2(s[2 * pp][0], s[2 * pp][1]); pw.y = pk2(s[2 * pp][2], s[2 * pp][3]); pw.z = pk2(s[2 * pp + 1][0], s[2 * pp + 1][1]); pw.w = pk2(s[2 * pp + 1][2], s[2 * pp + 1][3]);
            const bf16x8 pf = __builtin_bit_cast(bf16x8, pw);
#pragma unroll
            for (int dt = 0; dt < 4; ++dt) {
                const LAS unsigned char* vp = VTs + (dt * 16 + n) * (VT_STRIDE * 2) + (pp * 32 + quad * 4) * 2;
                const u32x2 v0 = *(const LAS u32x2*)vp, v1 = *(const LAS u32x2*)(vp + 32);
                const u32x4 vw = {v0.x, v0.y, v1.x, v1.y};
                o[dt] = __builtin_amdgcn_mfma_f32_16x16x32_bf16(__builtin_bit_cast(bf16x8, vw), pf, o[dt], 0, 0, 0);
            }
        }
    }
#pragma unroll
    for (int dt = 0; dt < 4; ++dt) {
        const u32x2 zw = *(const u32x2*)(zp + dt * 16 + quad * 4);
        const f32x4 z = {pg8::bf_lo(zw.x), pg8::bf_hi(zw.x), pg8::bf_lo(zw.y), pg8::bf_hi(zw.y)};
        const f32x4 r = o[dt] * inv * z; u32x2 w; w.x = pk2(r[0], r[1]); w.y = pk2(r[2], r[3]);
        *(u32x2*)(op + dt * 16 + quad * 4) = w;
    }
}
__device__ __forceinline__ void p2_mixers(const Ptrs& P, LAS unsigned char* lds, int vcu, int G, int wave, int lane, int tid) {
    bf16_t* Z1 = (bf16_t*)(P.ws + WS_Z1); bf16_t* AB = (bf16_t*)(P.ws + WS_H); const float* stats = (const float*)(P.ws + WS_STATS);
    {
        LAS unsigned char* vnT = lds; LAS unsigned char* Wl = lds + 128 * A_STRIDE * 2; LAS float* mr = (LAS float*)(lds + 2 * 128 * A_STRIDE * 2);
        for (int un = vcu; un < (MP / CH) * NG; un += G) {
            const int ci = un >> 3, g = un & 7, row0 = ci * CH;
            if (tid < CH) {
                const f32x4* sp = (const f32x4*)(stats + (size_t)(row0 + tid) * 32); float s = 0.f, q = 0.f;
#pragma unroll
                for (int j = 0; j < 8; ++j) { const f32x4 v = sp[j]; s += v[0] + v[2]; q += v[1] + v[3]; }
                const float mean = s * (1.0f / AW), var = q * (1.0f / AW) - mean * mean;
                mr[tid * 2] = mean; mr[tid * 2 + 1] = 1.0f / sqrtf(fmaxf(var, 0.f) + EPS);
            }
#pragma unroll
            for (int i = 0; i < 8; ++i) { const int e = tid + i * NTHR, t = e >> 5, s0 = (e & 31) * 4;
                const f32x4 w = *(const f32x4*)(P.w_sp + ((size_t)g * CH + t) * CH + s0);
                u32x2 o; o.x = pk2(s0 <= t ? w[0] : 0.f, s0 + 1 <= t ? w[1] : 0.f); o.y = pk2(s0 + 2 <= t ? w[2] : 0.f, s0 + 3 <= t ? w[3] : 0.f);
                *(LAS u32x2*)(Wl + t * (A_STRIDE * 2) + s0 * 2) = o; }
            __syncthreads();
#pragma unroll
            for (int i = 0; i < 4; ++i) { const int e = tid + i * NTHR, s = e >> 4, c0 = (e & 15) * 8;
                f32x4 a, b; unpack8(*(const u32x4*)(Z1 + (size_t)(row0 + s) * Z1W + C_V + g * CH + c0), a, b);
                const float mean = mr[s * 2], rstd = mr[s * 2 + 1];
                const f32x4 g0 = *(const f32x4*)(P.ln_g + g * CH + c0), g1 = *(const f32x4*)(P.ln_g + g * CH + c0 + 4), b0 = *(const f32x4*)(P.ln_b + g * CH + c0), b1 = *(const f32x4*)(P.ln_b + g * CH + c0 + 4);
                a = (a - mean) * rstd * g0 + b0; b = (b - mean) * rstd * g1 + b1;
#pragma unroll
                for (int j = 0; j < 4; ++j) { *(LAS bf16_t*)(vnT + (c0 + j) * (A_STRIDE * 2) + s * 2) = (bf16_t)f2bf(a[j]); *(LAS bf16_t*)(vnT + (c0 + 4 + j) * (A_STRIDE * 2) + s * 2) = (bf16_t)f2bf(b[j]); } }
            __syncthreads();
            {
                const int n = lane & 15, quad = lane >> 4, t = wave * 16 + n; const int nks = (wave >> 1) + 1;
                f32x4 acc[8];
#pragma unroll
                for (int ct = 0; ct < 8; ++ct) acc[ct] = (f32x4){0.f, 0.f, 0.f, 0.f};
                for (int ks = 0; ks < nks; ++ks) {
                    const bf16x8 wf = *(const LAS bf16x8*)(Wl + t * (A_STRIDE * 2) + (ks * 32 + quad * 8) * 2);
#pragma unroll
                    for (int ct = 0; ct < 8; ++ct) { const bf16x8 vf = *(const LAS bf16x8*)(vnT + (ct * 16 + n) * (A_STRIDE * 2) + (ks * 32 + quad * 8) * 2);
                        acc[ct] = __builtin_amdgcn_mfma_f32_16x16x32_bf16(vf, wf, acc[ct], 0, 0, 0); }
                }
                const int row = row0 + t; const float bs = P.b_sp[g * CH + t];
#pragma unroll
                for (int ct = 0; ct < 8; ++ct) { const int col = g * CH + ct * 16 + quad * 4;
                    const u32x2 uw = *(const u32x2*)(Z1 + (size_t)row * Z1W + C_U + col), zw = *(const u32x2*)(Z1 + (size_t)row * Z1W + C_ZA + col);
                    const f32x4 uu = {pg8::bf_lo(uw.x), pg8::bf_hi(uw.x), pg8::bf_lo(uw.y), pg8::bf_hi(uw.y)}, zz = {pg8::bf_lo(zw.x), pg8::bf_hi(zw.x), pg8::bf_lo(zw.y), pg8::bf_hi(zw.y)};
                    const f32x4 r = uu * (acc[ct] + bs) * zz; u32x2 w; w.x = pk2(r[0], r[1]); w.y = pk2(r[2], r[3]);
                    *(u32x2*)(AB + (size_t)row * 2048 + col) = w; }
            }
            __syncthreads();
        }
    }
    {
        LAS float* mr = (LAS float*)lds;
        for (int db = vcu; db < DB; db += G) {
            const int row0 = MP + db * DS;
            if (tid < DS) {
                const f32x4* sp = (const f32x4*)(stats + (size_t)(row0 + tid) * 32); float s = 0.f, q = 0.f;
#pragma unroll
                for (int j = 0; j < 8; ++j) { const f32x4 v = sp[j]; s += v[0] + v[2]; q += v[1] + v[3]; }
                const float mean = s * (1.0f / AW), var = q * (1.0f / AW) - mean * mean;
                mr[tid * 2] = mean; mr[tid * 2 + 1] = 1.0f / sqrtf(fmaxf(var, 0.f) + EPS);
            }
            __syncthreads();
            const int c = tid * 2, g = c >> 7;
            const f32x2 lg = *(const f32x2*)(P.ln_g + c), lb = *(const f32x2*)(P.ln_b + c);
            f32x2 vn[DS];
#pragma unroll
            for (int s = 0; s < DS; ++s) { const unsigned w = *(const unsigned*)(Z1 + (size_t)(row0 + s) * Z1W + C_V + c);
                const float mean = mr[s * 2], rstd = mr[s * 2 + 1];
                vn[s] = (f32x2){(pg8::bf_lo(w) - mean) * rstd * lg.x + lb.x, (pg8::bf_hi(w) - mean) * rstd * lg.y + lb.y};
                *(f32x2*)(P.out + O_CV + (size_t)(db * DS + s) * AW + c) = vn[s]; }
#pragma unroll
            for (int t = 0; t < DS; ++t) {
                const float bs = P.b_sp[g * CH + t]; f32x2 acc = {bs, bs};
#pragma unroll
                for (int s = 0; s <= t; ++s) { const float w = P.w_sp[((size_t)g * CH + t) * CH + s]; acc += vn[s] * w; }
                const unsigned uw = *(const unsigned*)(Z1 + (size_t)(row0 + t) * Z1W + C_U + c), zw = *(const unsigned*)(Z1 + (size_t)(row0 + t) * Z1W + C_ZA + c);
                *(unsigned*)(AB + (size_t)(row0 + t) * 2048 + c) = pk2(pg8::bf_lo(uw) * acc.x * pg8::bf_lo(zw), pg8::bf_hi(uw) * acc.y * pg8::bf_hi(zw));
            }
            __syncthreads();
        }
    }
    LAS unsigned char* Ks = lds; LAS unsigned char* VTs = lds + 256 * KS_STRIDE * 2;
    for (int un = vcu; un < NB * NKV * (SEQ / WIN); un += G) {
        const int blk = un & 15, kvh = (un >> 4) & 3, b = un >> 6; const bool first = blk == 0;
        const int krow0 = b * SEQ + (blk - 1) * WIN;
#pragma unroll
        for (int i = 0; i < 4; ++i) { const int e = tid + i * NTHR, key = e >> 3, c8 = (e & 7) * 8;
            if (!(first && key < WIN)) {
                const size_t zr = (size_t)(krow0 + key) * Z1W;
                const u32x4 kw = *(const u32x4*)(Z1 + zr + C_K + kvh * HD + c8);
                *(LAS u32x4*)(Ks + key * (KS_STRIDE * 2) + c8 * 2) = kw;
                const u32x4 vw = *(const u32x4*)(Z1 + zr + C_VA + kvh * HD + c8);
                LAS unsigned char* vt = VTs + c8 * (VT_STRIDE * 2) + key * 2;
                *(LAS bf16_t*)(vt + 0 * VT_STRIDE * 2) = (bf16_t)(vw.x & 0xffff); *(LAS bf16_t*)(vt + 1 * VT_STRIDE * 2) = (bf16_t)(vw.x >> 16);
                *(LAS bf16_t*)(vt + 2 * VT_STRIDE * 2) = (bf16_t)(vw.y & 0xffff); *(LAS bf16_t*)(vt + 3 * VT_STRIDE * 2) = (bf16_t)(vw.y >> 16);
                *(LAS bf16_t*)(vt + 4 * VT_STRIDE * 2) = (bf16_t)(vw.z & 0xffff); *(LAS bf16_t*)(vt + 5 * VT_STRIDE * 2) = (bf16_t)(vw.z >> 16);
                *(LAS bf16_t*)(vt + 6 * VT_STRIDE * 2) = (bf16_t)(vw.w & 0xffff); *(LAS bf16_t*)(vt + 7 * VT_STRIDE * 2) = (bf16_t)(vw.w >> 16);
            } }
        __syncthreads();
        {
            const int head = kvh * 4 + (wave >> 1); const float sink2 = P.sinks[head] * LOG2E;
            for (int q4 = 0; q4 < 4; ++q4) {
                const int qt = (wave & 1) * 4 + q4; const int row = b * SEQ + blk * WIN + qt * 16 + (lane & 15);
                attn_qtile<16, 0>(Z1 + (size_t)row * Z1W + C_Q + head * HD, Ks, VTs, lane, qt, first, sink2, AB + (size_t)row * 2048 + AW + head * HD, Z1 + (size_t)row * Z1W + C_ZB + head * HD);
            }
        }
        __syncthreads();
    }
    for (int un = vcu; un < DB * NKV; un += G) {
        const int kvh = un & 3, db = un >> 2; const int row0 = MP + db * DS;
#pragma unroll
        for (int i = 0; i < 4; ++i) { const int e = tid + i * NTHR, key = e >> 4, d0 = (e & 15) * 4;
            const size_t src = ((size_t)(db * WIN + key) * NKV + kvh) * HD + d0;
            const f32x4 kv = *(const f32x4*)(P.ck + src); const f32x4 vv = *(const f32x4*)(P.cv + src);
            const int i0 = d0 & 31, eo = d0 >> 5;
#pragma unroll
            for (int j = 0; j < 4; ++j) { *(LAS bf16_t*)(Ks + key * (KS_STRIDE * 2) + (2 * (i0 + j) + eo) * 2) = (bf16_t)f2bf(kv[j]);
                                          *(LAS bf16_t*)(VTs + (d0 + j) * (VT_STRIDE * 2) + key * 2) = (bf16_t)f2bf(vv[j]); } }
        if (tid < 32 * 8) { const int key = 128 + (tid >> 3), c8 = (tid & 7) * 8; u32x4 kw = {0u, 0u, 0u, 0u}, vw = {0u, 0u, 0u, 0u};
            if (key < 128 + DS) { const size_t zr = (size_t)(row0 + key - 128) * Z1W; kw = *(const u32x4*)(Z1 + zr + C_K + kvh * HD + c8); vw = *(const u32x4*)(Z1 + zr + C_VA + kvh * HD + c8); }
            *(LAS u32x4*)(Ks + key * (KS_STRIDE * 2) + c8 * 2) = kw;
            LAS unsigned char* vt = VTs + c8 * (VT_STRIDE * 2) + key * 2;
            *(LAS bf16_t*)(vt + 0 * VT_STRIDE * 2) = (bf16_t)(vw.x & 0xffff); *(LAS bf16_t*)(vt + 1 * VT_STRIDE * 2) = (bf16_t)(vw.x >> 16);
            *(LAS bf16_t*)(vt + 2 * VT_STRIDE * 2) = (bf16_t)(vw.y & 0xffff); *(LAS bf16_t*)(vt + 3 * VT_STRIDE * 2) = (bf16_t)(vw.y >> 16);
            *(LAS bf16_t*)(vt + 4 * VT_STRIDE * 2) = (bf16_t)(vw.z & 0xffff); *(LAS bf16_t*)(vt + 5 * VT_STRIDE * 2) = (bf16_t)(vw.z >> 16);
            *(LAS bf16_t*)(vt + 6 * VT_STRIDE * 2) = (bf16_t)(vw.w & 0xffff); *(LAS bf16_t*)(vt + 7 * VT_STRIDE * 2) = (bf16_t)(vw.w >> 16);
        }
        __syncthreads();
        if (wave < 2) {
            const int n = lane & 15; const int head = kvh * 4 + wave * 2 + (n >> 3); const int row = row0 + (n & 7);
            attn_qtile<10, 1>(Z1 + (size_t)row * Z1W + C_Q + head * HD, Ks, VTs, lane, 0, false, P.sinks[head] * LOG2E, AB + (size_t)row * 2048 + AW + head * HD, Z1 + (size_t)row * Z1W + C_ZB + head * HD);
        }
        __syncthreads();
    }
}

__device__ __forceinline__ void p5_final(const Ptrs& P, int vcu, int G, int wave, int lane) {
    const int gw = vcu * NWAVES + wave, NGW = G * NWAVES; const float* ssq = (const float*)(P.ws + WS_SSQ);
    for (int m = gw; m < M; m += NGW) {
        const float part = lane < 32 ? ssq[(size_t)m * 32 + lane] : 0.f;
        const float rstd = 1.0f / sqrtf(wave_sum(part) * (1.0f / DM) + EPS);
        const float* xrow = m < MP ? P.xp + (size_t)m * DM : P.xs + (size_t)(m - MP) * DM;
        f32x4* y = (f32x4*)(P.out + O_Y + (size_t)m * DM) + lane; const f32x4* xr = (const f32x4*)xrow + lane;
#pragma unroll
        for (int j = 0; j < 8; ++j) { const f32x4 g = ((const f32x4*)P.g_post)[lane + 64 * j]; y[64 * j] = xr[64 * j] + y[64 * j] * rstd * g; }
    }
}

struct Args { Ptrs p; int ph_lo, ph_hi; };
typedef const __attribute__((address_space(4))) Args* KArgPtr;
__device__ __forceinline__ Ptrs load_ptrs() {
    KArgPtr ap = (KArgPtr)__builtin_amdgcn_kernarg_segment_ptr(); asm volatile("" : "+s"(ap));
    Ptrs P; P.xp = ap->p.xp; P.xs = ap->p.xs; P.ck = ap->p.ck; P.cv = ap->p.cv; P.g_pre = ap->p.g_pre; P.w_in = ap->p.w_in; P.ln_g = ap->p.ln_g; P.ln_b = ap->p.ln_b;
    P.w_sp = ap->p.w_sp; P.b_sp = ap->p.b_sp; P.sinks = ap->p.sinks; P.w_pa = ap->p.w_pa; P.w_pb = ap->p.w_pb; P.w_out = ap->p.w_out; P.g_post = ap->p.g_post; P.out = ap->p.out; P.ws = ap->p.ws;
    return P;
}
__global__ void __launch_bounds__(NTHR, 2) fwd_kernel(Args args) {
    extern __shared__ __attribute__((aligned(16))) unsigned char lds_raw[];
    LAS unsigned char* lds = (LAS unsigned char*)lds_raw;
    const int tid = threadIdx.x, lane = tid & 63, wave = __builtin_amdgcn_readfirstlane(tid >> 6);
    const int G = gridDim.x, bx = blockIdx.x; const int vcu = (G % 8 == 0) ? (bx % 8) * (G / 8) + bx / 8 : bx;
    const int lo = args.ph_lo, hi = args.ph_hi;
#ifndef PH_MASK
#define PH_MASK 63
#endif
#define IN(k) (((PH_MASK >> (k)) & 1) && lo <= (k) && (k) < hi)
#define SEAM(k) do { if (IN(k) && IN((k) + 1)) cg::this_grid().sync(); } while (0)
    if (IN(0)) { const Ptrs P = load_ptrs(); p0_prologue(P, lds, vcu, G, wave, lane, tid); __syncthreads(); }
    SEAM(0);
    if (IN(1)) {
        const Ptrs P = load_ptrs();
        bf16_t* WinT = (bf16_t*)(P.ws + WS_WIN); bf16_t* H = (bf16_t*)(P.ws + WS_H);
        pg8::Gemm g; g.A0 = H; g.A1 = H; g.Bt0 = WinT; g.Bt1 = WinT; g.K = DM;
        pg8::StaticOrder S; S.init(M, INC, G, bx, 1);
        EpiIn E{(bf16_t*)(P.ws + WS_Z1), (bf16_t*)(P.ws + WS_G), (float*)(P.ws + WS_STATS), (const float*)(P.ws + WS_ROPE), P.out};
        pg8::gemm_phase<EpiIn, pg8::StaticOrder, true, true>(lds, g, S, E);
    }
    SEAM(1);
    if (IN(2)) { const Ptrs P = load_ptrs(); p2_mixers(P, lds, vcu, G, wave, lane, tid); }
    SEAM(2);
    if (IN(3)) {
        const Ptrs P = load_ptrs();
        bf16_t* WpT = (bf16_t*)(P.ws + WS_WP); bf16_t* H = (bf16_t*)(P.ws + WS_H);
        pg8::Gemm g; g.A0 = H; g.A1 = H + AW; g.Bt0 = WpT; g.Bt1 = WpT + AW; g.K = AW;
        pg8::StaticOrder S; S.init(M, DM, G, bx, 2);
        EpiMerge E{(const bf16_t*)(P.ws + WS_G), (bf16_t*)(P.ws + WS_Z1)};
        pg8::gemm_phase<EpiMerge, pg8::StaticOrder, true, true>(lds, g, S, E);
    }
    SEAM(3);
    if (IN(4)) {
        const Ptrs P = load_ptrs();
        bf16_t* WoutT = (bf16_t*)(P.ws + WS_WOUT); bf16_t* MG = (bf16_t*)(P.ws + WS_Z1);
        pg8::Gemm g; g.A0 = MG; g.A1 = MG; g.Bt0 = WoutT; g.Bt1 = WoutT; g.K = DM;
        pg8::StaticOrder S; S.init(M, DM, G, bx, 1);
        EpiOut E{P.out + O_Y, (float*)(P.ws + WS_SSQ)};
        pg8::gemm_phase<EpiOut, pg8::StaticOrder, true, true>(lds, g, S, E);
    }
    SEAM(4);
    if (IN(5)) { const Ptrs P = load_ptrs(); p5_final(P, vcu, G, wave, lane); }
#undef IN
#undef SEAM
}

extern "C" void kernel_launch(void* const* d_in, const int* in_sizes, int n_in, void* d_out, int out_size, void* d_ws, size_t ws_size, hipStream_t stream) {
    static int grid = 0;
    if (grid == 0) {
        if (n_in != 15 || in_sizes[0] != MP * DM || (size_t)out_size != O_END || ws_size < WS_END) {
            fprintf(stderr, "kernel_launch: unexpected shapes (n_in %d, in0 %d, out %d, ws %zu, need %zu)\n", n_in, n_in > 0 ? in_sizes[0] : -1, out_size, ws_size, (size_t)WS_END); grid = -1; return; }
        if (hipFuncSetAttribute((const void*)fwd_kernel, hipFuncAttributeMaxDynamicSharedMemorySize, LDS_BYTES) != hipSuccess) { fprintf(stderr, "kernel_launch: hipFuncSetAttribute failed\n"); grid = -1; return; }
        int dev = 0, cus = 0, per_cu = 0;
        hipGetDevice(&dev); hipDeviceGetAttribute(&cus, hipDeviceAttributeMultiprocessorCount, dev);
        hipOccupancyMaxActiveBlocksPerMultiprocessor(&per_cu, (const void*)fwd_kernel, NTHR, LDS_BYTES);
        if (per_cu < 1) { fprintf(stderr, "kernel_launch: occupancy query says %d blocks per CU\n", per_cu); per_cu = 1; }
        (void)hipGetLastError();
        grid = cus;
    }
    if (grid < 0) return;
    Args a{};
    a.p.xp = (const float*)d_in[0]; a.p.xs = (const float*)d_in[1]; a.p.ck = (const float*)d_in[2]; a.p.cv = (const float*)d_in[3]; a.p.g_pre = (const float*)d_in[4];
    a.p.w_in = (const float*)d_in[5]; a.p.ln_g = (const float*)d_in[6]; a.p.ln_b = (const float*)d_in[7]; a.p.w_sp = (const float*)d_in[8]; a.p.b_sp = (const float*)d_in[9];
    a.p.sinks = (const float*)d_in[10]; a.p.w_pa = (const float*)d_in[11]; a.p.w_pb = (const float*)d_in[12]; a.p.w_out = (const float*)d_in[13]; a.p.g_post = (const float*)d_in[14];
    a.p.out = (float*)d_out; a.p.ws = (unsigned char*)d_ws;
#if MK_N_LAUNCHES == 1
    a.ph_lo = 0; a.ph_hi = 6;
    void* kargs[] = {&a};
    hipError_t e = hipLaunchCooperativeKernel((const void*)fwd_kernel, dim3(grid), dim3(NTHR), kargs, LDS_BYTES, stream);
    if (e != hipSuccess) fprintf(stderr, "kernel_launch: cooperative launch failed: %s (grid %d)\n", hipGetErrorString(e), grid);
#else
    for (int ph = 0; ph < 6; ++ph) { a.ph_lo = ph; a.ph_hi = ph + 1; hipLaunchKernelGGL(fwd_kernel, dim3(grid), dim3(NTHR), LDS_BYTES, stream, a); }
#endif
}
```

```cpp
#include <hip/hip_runtime.h>
#include <hip/hip_cooperative_groups.h>
#include <cstdio>
#include <cstdint>
namespace cg = cooperative_groups;

#ifndef MK_N_LAUNCHES
#define MK_N_LAUNCHES 1
#endif

namespace pg8 {
#define PG8_LAS __attribute__((address_space(3)))
typedef unsigned short bf16_t;
typedef short bf16x8 __attribute__((ext_vector_type(8)));
typedef float f32x4 __attribute__((ext_vector_type(4)));
typedef float f32x2 __attribute__((ext_vector_type(2)));
typedef unsigned u32x4 __attribute__((ext_vector_type(4)));
typedef unsigned u32x2 __attribute__((ext_vector_type(2)));
constexpr int BM = 256, BK = 64, HALF = 128, HTB = HALF * BK * 2  , STAGE_BYTES = 8 * HTB, NXCD = 8, WGM = 8;

__host__ __device__ __forceinline__ int lds_byte(int r, int c) { const int st = (r >> 4) * 2 + (c >> 5), rr = r & 15, cc = c & 31, ob = rr * 64 + cc * 2; return st * 1024 + (ob ^ (((ob >> 9) & 1) << 5)); }
__host__ __device__ __forceinline__ void stage_rc(int b, int& R, int& C) { const int st = b / 1024, sb = b % 1024, swz = sb ^ (((sb >> 9) & 1) << 5); R = (st >> 1) * 16 + swz / 64; C = (st & 1) * 32 + (swz % 64) / 2; }
__host__ __device__ __forceinline__ int perm32(int rho) { const int n = rho >> 4, i = rho & 15; return 8 * (i >> 2) + 4 * n + (i & 3); }

struct Unit { int pm, pn, kh; };
struct Gemm { const bf16_t *A0, *A1, *Bt0, *Bt1; int K; };

struct StaticOrder {
    int nM, nN, nwg, G, c, nkh;
    __device__ void init(int M, int N, int G_, int c_, int nkh_) { nM = M / BM; nN = N / BM; nwg = nM * nN; G = G_; c = c_; nkh = nkh_; }
    __device__ bool next(int i, Unit& u) const {
        const int ti = (nkh == 2) ? (i >> 1) : i; u.kh = (nkh == 2) ? (i & 1) : 0;
        const long L = (long)ti * G + c; if (L >= nwg) return false;
        int wgid = (int)L; { const int q = nwg / NXCD, r = nwg % NXCD, xcd = wgid % NXCD, off = wgid / NXCD; wgid = (xcd < r ? xcd * (q + 1) : r * (q + 1) + (xcd - r) * q) + off; }
        const int nig = WGM * nN, gid = wgid / nig, fm = gid * WGM, gsz = (nM - fm) < WGM ? (nM - fm) : WGM;
        u.pm = fm + ((wgid % nig) % gsz); u.pn = (wgid % nig) / gsz; return true;
    }
    __device__ __forceinline__ void a_ready(const Unit&) const {}
    __device__ __forceinline__ void done(const Unit&) const {}
};

__device__ __forceinline__ unsigned cvt_pk_bf16(float lo, float hi) { unsigned r; asm volatile("v_cvt_pk_bf16_f32 %0, %1, %2" : "=v"(r) : "v"(lo), "v"(hi)); return r; }
__device__ __forceinline__ u32x4 pack8(f32x4 a, f32x4 b) { u32x4 w; w.x = cvt_pk_bf16(a[0], a[1]); w.y = cvt_pk_bf16(a[2], a[3]); w.z = cvt_pk_bf16(b[0], b[1]); w.w = cvt_pk_bf16(b[2], b[3]); return w; }
__device__ __forceinline__ float bf_lo(unsigned w) { return __uint_as_float(w << 16); }
__device__ __forceinline__ float bf_hi(unsigned w) { return __uint_as_float(w & 0xffff0000u); }
__device__ __forceinline__ f32x2 gelu_pk(f32x2 v) {
    const f32x2 av = __builtin_elementwise_abs(v), d = av * 0.2316418882f + 1.0f;
    f32x2 t; t.x = __builtin_amdgcn_rcpf(d.x); t.y = __builtin_amdgcn_rcpf(d.y);
    f32x2 q = t * 0.5307027145f + (-0.7265760135f); q = q * t + 0.7107068705f; q = q * t + (-0.142248368f); q = q * t + 0.127414796f; q = q * t;
    const f32x2 s = (v * v) * (-0.72134752044f);
    f32x2 e; e.x = __builtin_amdgcn_exp2f(s.x); e.y = __builtin_amdgcn_exp2f(s.y);
    const f32x2 m = v * (q * e), r = v - m;
    f32x2 o; o.x = v.x < 0.f ? m.x : r.x; o.y = v.y < 0.f ? m.y : r.y; return o;
}
__device__ __forceinline__ f32x4 gelu4(f32x4 v) { const f32x2 a = gelu_pk((f32x2){v[0], v[1]}), b = gelu_pk((f32x2){v[2], v[3]}); return (f32x4){a.x, a.y, b.x, b.y}; }
__device__ __forceinline__ float sigm(float x) { return __builtin_amdgcn_rcpf(1.0f + __builtin_amdgcn_exp2f(-1.4426950408889634f * x)); }
__device__ __forceinline__ f32x4 sigm4(f32x4 v) { return (f32x4){sigm(v[0]), sigm(v[1]), sigm(v[2]), sigm(v[3])}; }
__device__ __forceinline__ f32x4 silu4(f32x4 v) { return v * sigm4(v); }

template <class Epi, class Sched, bool ALIGN_EPI = false, bool SP2 = false>
__device__ __forceinline__ void gemm_phase(PG8_LAS unsigned char* lds, const Gemm g, const Sched& S, const Epi& E) {
    const int tid = threadIdx.x, wid = __builtin_amdgcn_readfirstlane(tid >> 6), lane = tid & 63, wr = wid >> 2, wc = wid & 3, fr = lane & 15, fq = lane >> 4;
    const int K = g.K, nt = K / BK; constexpr int lda = 2048, ldb = 2048;
    unsigned voffA[2], voffB[2];
#pragma unroll
    for (int i = 0; i < 2; ++i) { int R, C; stage_rc(tid * 16 + i * 8192, R, C); const int Rb = Epi::PERM ? ((R & ~31) + perm32(R & 31)) : R;
        voffA[i] = (unsigned)(R * lda + C) * 2u; voffB[i] = (unsigned)(Rb * ldb + C) * 2u; }
    const size_t kstep = (size_t)(BK * 2);
    const size_t hstepA = (size_t)HALF * lda * 2, hstepB = (size_t)HALF * ldb * 2;
    const size_t tstepA = 2 * hstepA, tstepB = 2 * hstepB;
    const unsigned ldsw = (unsigned)wid * 1024u;
    const int aoff = lds_byte(wr * 64 + fr, fq * 8), boff = lds_byte(wc * 32 + fr, fq * 8);
#define PG8_SA(b, h) (((b) * 2 + (h)) * HTB)
#define PG8_SB(b, h) ((4 + (b) * 2 + (h)) * HTB)
#define PG8_STAGE(bufoff, gbase, voff) do { _Pragma("unroll") for (int _i = 0; _i < 2; ++_i) \
        __builtin_amdgcn_global_load_lds((const unsigned*)((const char*)(gbase) + (voff)[_i]), (PG8_LAS unsigned*)(lds + (bufoff) + ldsw + _i * 8192), 16, 0, 0); } while (0)
#define PG8_LDA(dst, b, h) do { _Pragma("unroll") for (int m = 0; m < 4; ++m) _Pragma("unroll") for (int k = 0; k < 2; ++k) dst[m][k] = *(const PG8_LAS bf16x8*)(lds + PG8_SA(b, h) + aoff + m * 2048 + k * 1024); } while (0)
#define PG8_LDB(dst, b, h) do { _Pragma("unroll") for (int n = 0; n < 2; ++n) _Pragma("unroll") for (int k = 0; k < 2; ++k) dst[n][k] = *(const PG8_LAS bf16x8*)(lds + PG8_SB(b, h) + boff + n * 2048 + k * 1024); } while (0)
#define PG8_MMA(ai, bj, At, Bt) do { __builtin_amdgcn_s_setprio(1); _Pragma("unroll") for (int m = 0; m < 4; ++m) _Pragma("unroll") for (int n = 0; n < 2; ++n) _Pragma("unroll") for (int k = 0; k < 2; ++k) \
        acc[ai][bj][m][n] = __builtin_amdgcn_mfma_f32_16x16x32_bf16(Bt[n][k], At[m][k], acc[ai][bj][m][n], 0, 0, 0); __builtin_amdgcn_s_setprio(0); } while (0)
#define PG8_WAIT_V(n) asm volatile("s_waitcnt vmcnt(" #n ")" ::: "memory")
#define PG8_WAIT_L(n) asm volatile("s_waitcnt lgkmcnt(" #n ")" ::: "memory")
#define PG8_BAR __builtin_amdgcn_s_barrier()
#define PG8_SCHED __builtin_amdgcn_sched_barrier(0)
    Unit cur, nxt; int ui = 0;
    if (!S.next(0, cur)) return;
    f32x4 acc[2][2][4][2];
#pragma unroll
    for (int a = 0; a < 2; ++a)
#pragma unroll
        for (int b = 0; b < 2; ++b)
#pragma unroll
            for (int m = 0; m < 4; ++m)
#pragma unroll
                for (int n = 0; n < 2; ++n) acc[a][b][m][n] = (f32x4){0.f, 0.f, 0.f, 0.f};
    bf16x8 At[4][2], B0[2][2], B1[2][2];
    const char* cA = (const char*)(cur.kh ? g.A1 : g.A0) + (size_t)cur.pm * tstepA; const char* cB = (const char*)(cur.kh ? g.Bt1 : g.Bt0) + (size_t)cur.pn * tstepB;
    S.a_ready(cur);
    if constexpr (SP2) {
        PG8_STAGE(PG8_SB(0, 0), cB, voffB); PG8_STAGE(PG8_SB(0, 1), cB + hstepB, voffB); PG8_STAGE(PG8_SA(0, 0), cA, voffA); PG8_STAGE(PG8_SA(0, 1), cA + hstepA, voffA);
        if (wr == 1) PG8_BAR;
        PG8_WAIT_V(2); PG8_BAR;
        PG8_STAGE(PG8_SB(1, 0), cB + kstep, voffB); PG8_STAGE(PG8_SA(1, 0), cA + kstep, voffA); PG8_STAGE(PG8_SB(1, 1), cB + hstepB + kstep, voffB);
        PG8_WAIT_V(6); PG8_BAR;
    } else {
        PG8_STAGE(PG8_SB(0, 0), cB, voffB); PG8_STAGE(PG8_SA(0, 0), cA, voffA); PG8_STAGE(PG8_SB(0, 1), cB + hstepB, voffB); PG8_STAGE(PG8_SA(0, 1), cA + hstepA, voffA);
        if (wr == 1) PG8_BAR;
        PG8_WAIT_V(4); PG8_BAR;
        PG8_STAGE(PG8_SB(1, 0), cB + kstep, voffB); PG8_STAGE(PG8_SA(1, 0), cA + kstep, voffA); PG8_STAGE(PG8_SB(1, 1), cB + hstepB + kstep, voffB);
        PG8_WAIT_V(6); PG8_BAR;
    }
    for (;;) {
        const bool has_next = S.next(ui + 1, nxt);
        const char* nA = has_next ? (const char*)(nxt.kh ? g.A1 : g.A0) + (size_t)nxt.pm * tstepA : cA; const char* nB = has_next ? (const char*)(nxt.kh ? g.Bt1 : g.Bt0) + (size_t)nxt.pn * tstepB : cB;
        for (int t = 0; t < nt; t += 2) {
            const bool last = (t == nt - 2);
            const char* a1 = cA + (size_t)(t + 1) * kstep;
            const char* a2 = last ? nA : cA + (size_t)(t + 2) * kstep; const char* b2 = last ? nB : cB + (size_t)(t + 2) * kstep;
            const char* a3 = a2 + kstep; const char* b3 = b2 + kstep;
            if (last && has_next) S.a_ready(nxt);
            if constexpr (SP2) {
            PG8_LDB(B0, 0, 0); PG8_LDB(B1, 0, 1); PG8_SCHED; PG8_LDA(At, 0, 0); PG8_STAGE(PG8_SA(1, 1), a1 + hstepA, voffA);
            PG8_WAIT_V(8); PG8_WAIT_L(0); PG8_BAR; PG8_MMA(0, 0, At, B0); PG8_MMA(0, 1, At, B1); PG8_BAR; PG8_SCHED;
            PG8_LDA(At, 0, 1); PG8_STAGE(PG8_SB(0, 0), b2, voffB); PG8_STAGE(PG8_SB(0, 1), b2 + hstepB, voffB); PG8_STAGE(PG8_SA(0, 0), a2, voffA);
            PG8_WAIT_V(8); PG8_WAIT_L(0); PG8_BAR; PG8_MMA(1, 0, At, B0); PG8_MMA(1, 1, At, B1); PG8_BAR; PG8_SCHED;
            PG8_LDB(B0, 1, 0); PG8_LDB(B1, 1, 1); PG8_SCHED; PG8_LDA(At, 1, 0); PG8_STAGE(PG8_SA(0, 1), a2 + hstepA, voffA);
            PG8_WAIT_V(8); PG8_WAIT_L(0); PG8_BAR; PG8_MMA(0, 0, At, B0); PG8_MMA(0, 1, At, B1); PG8_BAR; PG8_SCHED;
            PG8_LDA(At, 1, 1); PG8_STAGE(PG8_SB(1, 0), b3, voffB); PG8_STAGE(PG8_SB(1, 1), b3 + hstepB, voffB); PG8_STAGE(PG8_SA(1, 0), a3, voffA);
            PG8_WAIT_V(8); PG8_WAIT_L(0); PG8_BAR; PG8_MMA(1, 0, At, B0); PG8_MMA(1, 1, At, B1); PG8_BAR; PG8_SCHED;
            } else {
            PG8_LDB(B0, 0, 0); PG8_SCHED; PG8_LDA(At, 0, 0); PG8_STAGE(PG8_SA(1, 1), a1 + hstepA, voffA);
            PG8_WAIT_L(8); PG8_BAR; PG8_WAIT_L(0); PG8_MMA(0, 0, At, B0); PG8_BAR; PG8_SCHED;
            PG8_LDB(B1, 0, 1); PG8_STAGE(PG8_SB(0, 0), b2, voffB);
            PG8_BAR; PG8_WAIT_L(0); PG8_MMA(0, 1, At, B1); PG8_BAR;
            PG8_LDA(At, 0, 1); PG8_STAGE(PG8_SA(0, 0), a2, voffA);
            PG8_BAR; PG8_WAIT_L(0); PG8_MMA(1, 0, At, B0); PG8_BAR; PG8_SCHED;
            PG8_STAGE(PG8_SB(0, 1), b2 + hstepB, voffB);
            PG8_WAIT_V(6); PG8_BAR; PG8_MMA(1, 1, At, B1); PG8_BAR;
            PG8_LDB(B0, 1, 0); PG8_SCHED; PG8_LDA(At, 1, 0); PG8_STAGE(PG8_SA(0, 1), a2 + hstepA, voffA);
            PG8_WAIT_L(8); PG8_BAR; PG8_WAIT_L(0); PG8_MMA(0, 0, At, B0); PG8_BAR; PG8_SCHED;
            PG8_LDB(B1, 1, 1); PG8_STAGE(PG8_SB(1, 0), b3, voffB);
            PG8_BAR; PG8_WAIT_L(0); PG8_MMA(0, 1, At, B1); PG8_BAR;
            PG8_LDA(At, 1, 1); PG8_STAGE(PG8_SA(1, 0), a3, voffA);
            PG8_BAR; PG8_WAIT_L(0); PG8_MMA(1, 0, At, B0); PG8_BAR; PG8_SCHED;
            PG8_STAGE(PG8_SB(1, 1), b3 + hstepB, voffB);
            PG8_WAIT_V(6); PG8_BAR; PG8_MMA(1, 1, At, B1); PG8_BAR;
            }
        }
        if constexpr (ALIGN_EPI) { if (wr == 0) PG8_BAR; }
        if constexpr (!Epi::AFTER_DRAIN) { E(acc, cur, wr, wc, fr, fq); S.done(cur); }
        if (!has_next) break;
        if (cur.kh == Epi::NKH - 1) {
#pragma unroll
        for (int a = 0; a < 2; ++a)
#pragma unroll
            for (int b = 0; b < 2; ++b)
#pragma unroll
                for (int m = 0; m < 4; ++m)
#pragma unroll
                    for (int n = 0; n < 2; ++n) acc[a][b][m][n] = (f32x4){0.f, 0.f, 0.f, 0.f};
        }
        cur = nxt; cA = nA; cB = nB; ++ui;
        if constexpr (ALIGN_EPI) { if (wr == 1) PG8_BAR; }
    }
    PG8_WAIT_V(0);
    if constexpr (!ALIGN_EPI) { if (wr == 0) PG8_BAR; }
    PG8_BAR;
    if constexpr (Epi::AFTER_DRAIN) { E.fused(acc, cur, wr, wc, fr, fq, lds, wid, lane); S.done(cur); }
#undef PG8_SA
#undef PG8_SB
#undef PG8_STAGE
#undef PG8_LDA
#undef PG8_LDB
#undef PG8_MMA
#undef PG8_WAIT_V
#undef PG8_WAIT_L
#undef PG8_BAR
#undef PG8_SCHED
}}

using pg8::bf16_t; using pg8::bf16x8; using pg8::f32x4; using pg8::f32x2; using pg8::u32x4; using pg8::u32x2; using pg8::Unit;
#define LAS __attribute__((address_space(3)))
typedef short s16x4 __attribute__((ext_vector_type(4)));

constexpr int NWAVES = 8, NTHR = 512;
constexpr int DM = 2048, NB = 8, SEQ = 2048, DB = 128, DS = 8, PAST = 8192;
constexpr int MP = NB * SEQ, MS = DB * DS, M = MP + MS;
constexpr int AW = 1024, NG = 8, CH = 128, HD = 64, NH = 16, NKV = 4, BW = 1024, KVW = 256, WIN = 128;
constexpr int INC = 3 * AW + 2 * BW + 2 * KVW + 2 * DM;
constexpr int Z1W = 5632, GW = 4096;
constexpr int C_U = 0, C_V = 1024, C_ZA = 2048, C_Q = 3072, C_K = 4096, C_VA = 4352, C_ZB = 4608;
constexpr float EPS = 1e-6f;
constexpr float QSCALE = 0.125f * 1.4426950408889634f;
constexpr float LOG2E = 1.4426950408889634f;
constexpr int NTPOS = SEQ + DS;

constexpr size_t O_Y = 0, O_KWP = (size_t)M * DM, O_VWP = O_KWP + (size_t)NB * WIN * KVW, O_KWS = O_VWP + (size_t)NB * WIN * KVW,
                 O_VWS = O_KWS + (size_t)DB * WIN * KVW, O_CV = O_VWS + (size_t)DB * WIN * KVW, O_END = O_CV + (size_t)MS * AW;

constexpr size_t al256(size_t x) { return (x + 255) & ~(size_t)255; }
constexpr size_t WS_CTL = 0, CTL_ZERO_BYTES = 16384;
constexpr size_t WS_ROPE = CTL_ZERO_BYTES;
constexpr size_t WS_STATS = al256(WS_ROPE + (size_t)NTPOS * 32 * 2 * 4);
constexpr size_t WS_SSQ = al256(WS_STATS + (size_t)M * 32 * 4);
constexpr size_t WS_WIN = al256(WS_SSQ + (size_t)M * 32 * 4);
constexpr size_t WS_WP = al256(WS_WIN + (size_t)INC * DM * 2);
constexpr size_t WS_WOUT = al256(WS_WP + (size_t)DM * 2048 * 2);
constexpr size_t WS_H = al256(WS_WOUT + (size_t)DM * DM * 2);
constexpr size_t WS_Z1 = al256(WS_H + (size_t)M * DM * 2);
constexpr size_t WS_G = al256(WS_Z1 + (size_t)M * Z1W * 2);
constexpr size_t WS_END = al256(WS_G + (size_t)M * GW * 2);

constexpr int LDS_BYTES = 139264;

enum { T_U = 0, T_V, T_ZA, T_Q, T_K, T_VA, T_ZB, T_G };
struct EpiIn {
    static constexpr bool PERM = true, AFTER_DRAIN = false; static constexpr int NKH = 1;
    bf16_t* Z1; bf16_t* G; float* stats; const float* rope; float* out;
    template <int TY> __device__ __forceinline__ void tile(f32x4 (&acc)[2][2][4][2], const Unit& u, int wr, int wc, int fr, int fq) const {
        const int cl = wc * 32 + 8 * fq; const int i0 = (16 * wc + 4 * fq) & 31;
        f32x4 rcs[2][4][2];
        if (TY == T_Q || TY == T_K) {
#pragma unroll
            for (int ai = 0; ai < 2; ++ai)
#pragma unroll
                for (int m = 0; m < 4; ++m) { const int row = u.pm * 256 + ai * 128 + wr * 64 + m * 16 + fr;
                    const int tpos = row < MP ? (row & (SEQ - 1)) : SEQ + ((row - MP) & (DS - 1));
                    const f32x4* rp = (const f32x4*)(rope + ((size_t)tpos * 32 + i0) * 2); rcs[ai][m][0] = rp[0]; rcs[ai][m][1] = rp[1]; }
        }
#pragma unroll
        for (int ai = 0; ai < 2; ++ai)
#pragma unroll
            for (int m = 0; m < 4; ++m) {
                const int row = u.pm * 256 + ai * 128 + wr * 64 + m * 16 + fr;
                f32x4 rc0 = {0.f, 0.f, 0.f, 0.f}, rc1 = {0.f, 0.f, 0.f, 0.f};
                if (TY == T_Q || TY == T_K) { rc0 = rcs[ai][m][0]; rc1 = rcs[ai][m][1]; }
                float ss = 0.f, sq = 0.f;
                bool win = false; size_t wbase = 0; float* wk = nullptr;
                if (TY == T_K || TY == T_VA) {
                    if (row < MP) { const int t = row & (SEQ - 1); win = t >= SEQ - WIN; wbase = ((size_t)(row >> 11) * WIN + (t - (SEQ - WIN))) * KVW; wk = out + (TY == T_K ? O_KWP : O_VWP); }
                    else { const int r = row - MP; win = true; wbase = ((size_t)(r >> 3) * WIN + (WIN - DS) + (r & 7)) * KVW; wk = out + (TY == T_K ? O_KWS : O_VWS); }
                }
#pragma unroll
                for (int bj = 0; bj < 2; ++bj) {
                    f32x4 a = acc[ai][bj][m][0], b = acc[ai][bj][m][1];
                    const int col = u.pn * 256 + bj * 128 + cl;
                    if (TY == T_U || TY == T_V) { a = pg8::gelu4(a); b = pg8::gelu4(b); }
                    if (TY == T_V) { ss += (a[0] + a[1]) + (a[2] + a[3]) + (b[0] + b[1]) + (b[2] + b[3]);
                        sq += (a[0] * a[0] + a[1] * a[1]) + (a[2] * a[2] + a[3] * a[3]) + (b[0] * b[0] + b[1] * b[1]) + (b[2] * b[2] + b[3] * b[3]); }
                    if (TY == T_ZA || TY == T_ZB) { a = pg8::silu4(a); b = pg8::silu4(b); }
                    if (TY == T_G) { a = pg8::sigm4(a); b = pg8::sigm4(b); }
                    if (TY == T_Q || TY == T_K) {
                        f32x4 ra, rb;
                        ra[0] = a[0] * rc0[0] - a[1] * rc0[1]; ra[1] = a[1] * rc0[0] + a[0] * rc0[1];
                        ra[2] = a[2] * rc0[2] - a[3] * rc0[3]; ra[3] = a[3] * rc0[2] + a[2] * rc0[3];
                        rb[0] = b[0] * rc1[0] - b[1] * rc1[1]; rb[1] = b[1] * rc1[0] + b[0] * rc1[1];
                        rb[2] = b[2] * rc1[2] - b[3] * rc1[3]; rb[3] = b[3] * rc1[2] + b[2] * rc1[3];
                        a = ra; b = rb;
                        if (TY == T_Q) { a = a * QSCALE; b = b * QSCALE; }
                    }
                    if (TY == T_K) { if (win) { float* o = wk + wbase + (bj * 2 + (wc >> 1)) * HD + i0;
                        *(f32x4*)o = (f32x4){a[0], a[2], b[0], b[2]}; *(f32x4*)(o + 32) = (f32x4){a[1], a[3], b[1], b[3]}; } }
                    if (TY == T_VA) { if (win) { float* o = wk + wbase + (bj * 2 + (wc >> 1)) * HD + (cl & 63); *(f32x4*)o = a; *(f32x4*)(o + 4) = b; } }
                    const u32x4 w = pg8::pack8(a, b);
                    if (TY == T_G) *(u32x4*)(G + (size_t)row * GW + (col - Z1W)) = w;
                    else *(u32x4*)(Z1 + (size_t)row * Z1W + col) = w;
                }
                if (TY == T_V) {
                    ss += __shfl_xor(ss, 16); ss += __shfl_xor(ss, 32); sq += __shfl_xor(sq, 16); sq += __shfl_xor(sq, 32);
                    if (fq == 0) *(f32x2*)(stats + ((size_t)row * 16 + (u.pn - 4) * 4 + wc) * 2) = (f32x2){ss, sq};
                }
            }
    }
    __device__ __forceinline__ void operator()(f32x4 (&acc)[2][2][4][2], const Unit& u, int wr, int wc, int fr, int fq) const {
        asm volatile("" : "+v"(fr), "+v"(fq));
        const int pn = u.pn;
        if (pn < 4) tile<T_U>(acc, u, wr, wc, fr, fq);
        else if (pn < 8) tile<T_V>(acc, u, wr, wc, fr, fq);
        else if (pn < 12) tile<T_ZA>(acc, u, wr, wc, fr, fq);
        else if (pn < 16) tile<T_Q>(acc, u, wr, wc, fr, fq);
        else if (pn == 16) tile<T_K>(acc, u, wr, wc, fr, fq);
        else if (pn == 17) tile<T_VA>(acc, u, wr, wc, fr, fq);
        else if (pn < 22) tile<T_ZB>(acc, u, wr, wc, fr, fq);
        else tile<T_G>(acc, u, wr, wc, fr, fq);
    }
};
__device__ __forceinline__ void unpack8(u32x4 w, f32x4& a, f32x4& b) {
    a = (f32x4){pg8::bf_lo(w.x), pg8::bf_hi(w.x), pg8::bf_lo(w.y), pg8::bf_hi(w.y)}; b = (f32x4){pg8::bf_lo(w.z), pg8::bf_hi(w.z), pg8::bf_lo(w.w), pg8::bf_hi(w.w)};
}
struct EpiMerge {
    static constexpr bool PERM = true, AFTER_DRAIN = false; static constexpr int NKH = 2;
    const bf16_t* G; bf16_t* MG;
    __device__ __forceinline__ void operator()(f32x4 (&acc)[2][2][4][2], const Unit& u, int wr, int wc, int fr, int fq) const {
        asm volatile("" : "+v"(fr), "+v"(fq));
        const int cl = wc * 32 + 8 * fq; const int row0 = u.pm * 256 + wr * 64 + fr;
        const bf16_t* gp = G + (size_t)row0 * GW + u.pn * 256 + cl;
        if (u.kh == 0) {
#pragma unroll
            for (int ai = 0; ai < 2; ++ai)
#pragma unroll
                for (int m = 0; m < 4; ++m)
#pragma unroll
                    for (int bj = 0; bj < 2; ++bj) {
                        const bf16_t* p = gp + (size_t)(ai * 128 + m * 16) * GW + bj * 128;
                        f32x4 sb0, sb1, sa0, sa1; unpack8(*(const u32x4*)(p + DM), sb0, sb1); unpack8(*(const u32x4*)p, sa0, sa1);
#pragma unroll
                        for (int j = 0; j < 4; ++j) { acc[ai][bj][m][0][j] *= sa0[j] * __builtin_amdgcn_rcpf(sb0[j]); acc[ai][bj][m][1][j] *= sa1[j] * __builtin_amdgcn_rcpf(sb1[j]); }
                    }
        } else {
            u32x4 sbw[2][4][2];
#pragma unroll
            for (int ai = 0; ai < 2; ++ai)
#pragma unroll
                for (int m = 0; m < 4; ++m)
#pragma unroll
                    for (int bj = 0; bj < 2; ++bj) sbw[ai][m][bj] = *(const u32x4*)(gp + (size_t)(ai * 128 + m * 16) * GW + bj * 128 + DM);
            asm volatile("" ::: "memory");
            bf16_t* op = MG + (size_t)row0 * DM + u.pn * 256 + cl;
#pragma unroll
            for (int ai = 0; ai < 2; ++ai)
#pragma unroll
                for (int m = 0; m < 4; ++m)
#pragma unroll
                    for (int bj = 0; bj < 2; ++bj) { f32x4 sb0, sb1; unpack8(sbw[ai][m][bj], sb0, sb1);
                        *(u32x4*)(op + (size_t)(ai * 128 + m * 16) * DM + bj * 128) = pg8::pack8(acc[ai][bj][m][0] * sb0, acc[ai][bj][m][1] * sb1); }
        }
    }
};
struct PanelOrder {
    int nwg, G, c;
    __device__ void init(int M, int G_, int c_) { nwg = (M / 256) * 8; G = G_; c = c_; }
    __device__ bool next(int i, Unit& u) const { const int L = i * G + c; if (L >= nwg) return false; u.pm = L >> 3; u.pn = L & 7; u.kh = 0; return true; }
    __device__ __forceinline__ void a_ready(const Unit&) const {}
    __device__ __forceinline__ void done(const Unit&) const {}
};
struct EpiOutNorm {
    static constexpr bool PERM = true, AFTER_DRAIN = false; static constexpr int NKH = 1;
    const float* xp; const float* xs; const float* g_post; float* Y; float* rowss; unsigned* cnt;
    template <int B> __device__ __forceinline__ void ldx(f32x4 (&xb)[2][2], const float* Xl) const {
#pragma unroll
        for (int bj = 0; bj < 2; ++bj) { const float* p = Xl + (size_t)((B >> 2) * 128 + (B & 3) * 16) * DM + bj * 128; xb[bj][0] = *(const f32x4*)p; xb[bj][1] = *(const f32x4*)(p + 4); }
    }
    template <int B> __device__ __forceinline__ void stx(const f32x4 (&xb)[2][2], f32x4 (&acc)[2][2][4][2], float* Yl, const float (&rstd)[8], const f32x4 (&gv)[2][2]) const {
#pragma unroll
        for (int bj = 0; bj < 2; ++bj) { constexpr int ai = B >> 2, m = B & 3; float* o = Yl + (size_t)(ai * 128 + m * 16) * DM + bj * 128; const float r = rstd[B];
            *(f32x4*)o = xb[bj][0] + acc[ai][bj][m][0] * r * gv[bj][0]; *(f32x4*)(o + 4) = xb[bj][1] + acc[ai][bj][m][1] * r * gv[bj][1]; }
    }
    __device__ __forceinline__ void operator()(f32x4 (&acc)[2][2][4][2], const Unit& u, int wr, int wc, int fr, int fq) const {
        asm volatile("" : "+v"(fr), "+v"(fq));
        const int cl = wc * 32 + 8 * fq; const int rbase = u.pm * 256 + wr * 64 + fr;
        const float* X = (u.pm < MP / 256) ? xp + (size_t)u.pm * 256 * DM : xs + (size_t)(u.pm - MP / 256) * 256 * DM;
        const float* Xl = X + (size_t)(wr * 64 + fr) * DM + u.pn * 256 + cl; float* Yl = Y + (size_t)rbase * DM + u.pn * 256 + cl;
        f32x4 xb0[2][2], xb1[2][2], xb2[2][2];
        ldx<0>(xb0, Xl);
        f32x4 gv[2][2];
#pragma unroll
        for (int bj = 0; bj < 2; ++bj) { gv[bj][0] = *(const f32x4*)(g_post + u.pn * 256 + bj * 128 + cl); gv[bj][1] = *(const f32x4*)(g_post + u.pn * 256 + bj * 128 + cl + 4); }
#pragma unroll
        for (int ai = 0; ai < 2; ++ai)
#pragma unroll
            for (int m = 0; m < 4; ++m) {
                float sq = 0.f;
#pragma unroll
                for (int bj = 0; bj < 2; ++bj) { const f32x4 a = acc[ai][bj][m][0], b = acc[ai][bj][m][1];
                    sq += (a[0] * a[0] + a[1] * a[1]) + (a[2] * a[2] + a[3] * a[3]) + (b[0] * b[0] + b[1] * b[1]) + (b[2] * b[2] + b[3] * b[3]); }
                sq += __shfl_xor(sq, 16); sq += __shfl_xor(sq, 32);
                if (fq == 0) (void)__hip_atomic_fetch_add(rowss + rbase + ai * 128 + m * 16, sq, __ATOMIC_RELAXED, __HIP_MEMORY_SCOPE_AGENT);
            }
        asm volatile("s_waitcnt vmcnt(0)" ::: "memory");
        unsigned* cw = cnt + 64 * u.pm;
        if (fr == 0 && fq == 0) (void)__hip_atomic_fetch_add(cw, 1u, __ATOMIC_RELAXED, __HIP_MEMORY_SCOPE_AGENT);
        { unsigned spins = 0;
          while ((unsigned)__builtin_amdgcn_readfirstlane(__hip_atomic_load(cw, __ATOMIC_RELAXED, __HIP_MEMORY_SCOPE_AGENT)) < 64u) { __builtin_amdgcn_s_sleep(1); if (++spins > (1u << 22)) break; } }
        __builtin_amdgcn_fence(__ATOMIC_ACQUIRE, "agent");
        float rstd[8];
#pragma unroll
        for (int i = 0; i < 8; ++i) rstd[i] = __hip_atomic_load(rowss + rbase + (i >> 2) * 128 + (i & 3) * 16, __ATOMIC_RELAXED, __HIP_MEMORY_SCOPE_AGENT);
#pragma unroll
        for (int i = 0; i < 8; ++i) rstd[i] = __builtin_amdgcn_rsqf(rstd[i] * (1.0f / DM) + EPS);
#define FENCE_ asm volatile("" ::: "memory")
        ldx<1>(xb1, Xl); ldx<2>(xb2, Xl); FENCE_; stx<0>(xb0, acc, Yl, rstd, gv); FENCE_;
        ldx<3>(xb0, Xl); FENCE_; stx<1>(xb1, acc, Yl, rstd, gv); FENCE_;
        ldx<4>(xb1, Xl); FENCE_; stx<2>(xb2, acc, Yl, rstd, gv); FENCE_;
        ldx<5>(xb2, Xl); FENCE_; stx<3>(xb0, acc, Yl, rstd, gv); FENCE_;
        ldx<6>(xb0, Xl); FENCE_; stx<4>(xb1, acc, Yl, rstd, gv); FENCE_;
        ldx<7>(xb1, Xl); FENCE_; stx<5>(xb2, acc, Yl, rstd, gv); FENCE_;
        stx<6>(xb0, acc, Yl, rstd, gv); stx<7>(xb1, acc, Yl, rstd, gv);
#undef FENCE_
    }
};
#define XB_TMO      128
#define XB_XCNT(j)  (256  + 64 * (j))
#define XB_XSUB(j)  (1280 + 64 * (j))
#define XB_XGEN(j)  (2304 + 64 * (j))
#define XB_TOP      3328
#define XB_TOPGEN   3392
#define XCD_BAR_WORDS 3456
#define XB_SPIN_CAP (1u << 18)

__device__ __forceinline__ unsigned xb_ld(unsigned* p)              { return __hip_atomic_load(p, __ATOMIC_RELAXED, __HIP_MEMORY_SCOPE_AGENT); }
__device__ __forceinline__ unsigned xb_add(unsigned* p, unsigned v) { return __hip_atomic_fetch_add(p, v, __ATOMIC_RELAXED, __HIP_MEMORY_SCOPE_AGENT); }
__device__ __forceinline__ unsigned xb_xcc_id() { return (unsigned)__builtin_amdgcn_s_getreg((3 << 11) | 20) & 0xFu; }
#define XB_SPIN(cond, bar) do { unsigned _sp = 0; while (cond) { __builtin_amdgcn_s_sleep(1); \
    if ((++_sp & 255u) == 0u) { if (xb_ld(&(bar)[XB_TMO])) break; if (_sp > XB_SPIN_CAP) { atomicAdd(&(bar)[XB_TMO], 1u); break; } } } } while (0)

struct XcdBarrier {
    unsigned* bar; unsigned x;
    volatile LAS unsigned* st;
};

__device__ __forceinline__ XcdBarrier xcd_barrier_post(unsigned* bar, volatile LAS unsigned* st) {
    XcdBarrier b; b.bar = bar; b.x = xb_xcc_id(); b.st = st;
    if (threadIdx.x == 0) (void)xb_add(&bar[XB_XCNT(b.x)], 1u);
    return b;
}
__device__ __forceinline__ void xcd_barrier_complete(unsigned* bar, unsigned x, unsigned& nloc, unsigned& nx) {
    const unsigned G = gridDim.x * gridDim.y * gridDim.z;
    unsigned sum, cnt, mine, sp = 0u;
    for (;;) {
        sum = 0u; cnt = 0u; mine = 0u;
#pragma unroll
        for (unsigned j = 0; j < 16; ++j) { const unsigned c = xb_ld(&bar[XB_XCNT(j)]); sum += c; cnt += (c > 0u) ? 1u : 0u; mine = (j == x) ? c : mine; }
        if (sum == G) break;
        __builtin_amdgcn_s_sleep(1);
        if ((++sp & 255u) == 0u) { if (xb_ld(&bar[XB_TMO])) break; if (sp > XB_SPIN_CAP) { atomicAdd(&bar[XB_TMO], 1u); break; } }
    }
    nloc = mine > 0u ? mine : 1u; nx = cnt > 0u ? cnt : 1u;
}

__device__ __forceinline__ void xcd_barrier(const XcdBarrier& b) {
    asm volatile("s_waitcnt vmcnt(0)" ::: "memory");
    __syncthreads();
    if (threadIdx.x == 0) {
        unsigned* bar = b.bar;
        __builtin_amdgcn_s_waitcnt(0);
        unsigned nloc = b.st[0], nx = b.st[1];
        if (nloc == 0u) { xcd_barrier_complete(bar, b.x, nloc, nx); b.st[0] = nloc; b.st[1] = nx; }
        const unsigned old = xb_add(&bar[XB_XSUB(b.x)], 1u);
        const unsigned gen = old / nloc;
        if (old + 1u == (gen + 1u) * nloc) {
            __builtin_amdgcn_fence(__ATOMIC_RELEASE, "agent");
            asm volatile("s_waitcnt vmcnt(0)" ::: "memory");
            const unsigned og = xb_add(&bar[XB_TOP], 1u);
            const unsigned tg = og / nx;
            if (og + 1u == (tg + 1u) * nx) xb_add(&bar[XB_TOPGEN], 1u);
            else XB_SPIN(xb_ld(&bar[XB_TOPGEN]) == tg, bar);
            __builtin_amdgcn_fence(__ATOMIC_ACQUIRE, "agent");
            xb_add(&bar[XB_XGEN(b.x)], 1u);
            asm volatile("s_waitcnt vmcnt(0)" ::: "memory");
        } else {
            XB_SPIN(xb_ld(&bar[XB_XGEN(b.x)]) == gen, bar);
            __builtin_amdgcn_fence(__ATOMIC_ACQUIRE, "agent");
            asm volatile("s_waitcnt vmcnt(0)" ::: "memory");
        }
    }
    __syncthreads();
}

__device__ __forceinline__ float wave_sum(float v) {
#pragma unroll
    for (int o = 1; o < 64; o <<= 1) v += __shfl_xor(v, o);
    return v;
}
__device__ __forceinline__ unsigned f2bf(float f) { unsigned u = __float_as_uint(f); return (u + 0x7fffu + ((u >> 16) & 1u)) >> 16; }
__device__ __forceinline__ unsigned pk2(float lo, float hi) { return pg8::cvt_pk_bf16(lo, hi); }
#define LDS_WAIT() asm volatile("s_waitcnt lgkmcnt(0)" ::: "memory")

struct Ptrs {
    const float *xp, *xs, *ck, *cv, *g_pre, *w_in, *ln_g, *ln_b, *w_sp, *b_sp, *sinks, *w_pa, *w_pb, *w_out, *g_post;
    float* out; unsigned char* ws;
};
static __device__ const double kInvFreq[32] = {1.0, 0.7498942093324559, 0.5623413251903491, 0.4216965034285822, 0.31622776601683794, 0.23713737056616552, 0.1778279410038923, 0.1333521432163324, 0.1, 0.07498942093324558, 0.05623413251903491, 0.042169650342858224, 0.03162277660168379, 0.023713737056616554, 0.01778279410038923, 0.01333521432163324, 0.01, 0.007498942093324558, 0.005623413251903491, 0.004216965034285823, 0.0031622776601683794, 0.0023713737056616554, 0.0017782794100389228, 0.001333521432163324, 0.001, 0.0007498942093324559, 0.0005623413251903491, 0.00042169650342858224, 0.00031622776601683794, 0.00023713737056616554, 0.00017782794100389227, 0.0001333521432163324};

template <bool QKPERM>
__device__ __forceinline__ void p0_transpose_item(const float* W, int N, bf16_t* WT, int ldt, int koff, LAS float* scr, int item, int lane) {
    const int nblk = N / 32, kb = item / nblk, nb = item % nblk, k0 = 64 * kb, n0 = 32 * nb;
#pragma unroll 8
    for (int i = 0; i < 32; ++i) { const int kk = 2 * i + (lane >> 5); scr[kk * 33 + (lane & 31)] = W[(size_t)(k0 + kk) * N + n0 + (lane & 31)]; }
    LDS_WAIT(); asm volatile("" ::: "memory");
    const int c = lane & 7;
#pragma unroll
    for (int j = 0; j < 4; ++j) { const int n = (lane >> 3) + 8 * j; const LAS float* s = scr + (8 * c) * 33 + n;
        u32x4 o; o.x = pk2(s[0 * 33], s[1 * 33]); o.y = pk2(s[2 * 33], s[3 * 33]); o.z = pk2(s[4 * 33], s[5 * 33]); o.w = pk2(s[6 * 33], s[7 * 33]);
        int nn = n0 + n;
        if (QKPERM) { if (nn >= C_Q && nn < C_VA) { const int d = nn & 63; nn = (nn & ~63) + 2 * (d & 31) + (d >> 5); } }
        *(u32x4*)(WT + (size_t)nn * ldt + koff + k0 + 8 * c) = o; }
    LDS_WAIT(); asm volatile("" ::: "memory");
}
__device__ __forceinline__ void p0_prologue(const Ptrs& P, LAS unsigned char* lds, int vcu, int G, int wave, int lane, int tid) {
    LAS float* scr = (LAS float*)(lds + wave * 16384);
    const int gw = vcu * NWAVES + wave, NGW = G * NWAVES;
    bf16_t* WinT = (bf16_t*)(P.ws + WS_WIN); bf16_t* WpT = (bf16_t*)(P.ws + WS_WP); bf16_t* WoutT = (bf16_t*)(P.ws + WS_WOUT);
    constexpr int I_IN = (DM / 64) * (INC / 32), I_PA = (AW / 64) * (DM / 32), I_PB = (BW / 64) * (DM / 32), I_OUT = (DM / 64) * (DM / 32);
    constexpr int NITEMS = I_IN + I_PA + I_PB + I_OUT;
    for (int it = gw; it < NITEMS; it += NGW) {
        int r = it;
        if (r < I_IN) { p0_transpose_item<true>(P.w_in, INC, WinT, DM, 0, scr, r, lane); continue; } r -= I_IN;
        if (r < I_PA) { p0_transpose_item<false>(P.w_pa, DM, WpT, 2048, 0, scr, r, lane); continue; } r -= I_PA;
        if (r < I_PB) { p0_transpose_item<false>(P.w_pb, DM, WpT, 2048, 1024, scr, r, lane); continue; } r -= I_PB;
        p0_transpose_item<false>(P.w_out, DM, WoutT, DM, 0, scr, r, lane);
    }
    bf16_t* H = (bf16_t*)(P.ws + WS_H);
    for (int m = gw; m < M; m += NGW) {
        const float* xrow = m < MP ? P.xp + (size_t)m * DM : P.xs + (size_t)(m - MP) * DM;
        const f32x4* xr = (const f32x4*)xrow + lane; f32x4 v[8]; float s = 0.f;
#pragma unroll
        for (int j = 0; j < 8; ++j) { v[j] = xr[64 * j]; s += (v[j][0] * v[j][0] + v[j][1] * v[j][1]) + (v[j][2] * v[j][2] + v[j][3] * v[j][3]); }
        const float rstd = 1.0f / sqrtf(wave_sum(s) * (1.0f / DM) + EPS);
        u32x2* o = (u32x2*)(H + (size_t)m * DM) + lane;
#pragma unroll
        for (int j = 0; j < 8; ++j) { const f32x4 g = ((const f32x4*)P.g_pre)[lane + 64 * j]; const f32x4 y = v[j] * rstd * g; u32x2 w; w.x = pk2(y[0], y[1]); w.y = pk2(y[2], y[3]); o[64 * j] = w; }
    }
    float* rope = (float*)(P.ws + WS_ROPE);
    const int gt = vcu * NTHR + tid, NGT = G * NTHR;
    for (int e = gt; e < NTPOS * 32; e += NGT) {
        const int tp = e >> 5, i = e & 31; const int pos = tp < SEQ ? tp : PAST + (tp - SEQ);
        const double a = (double)pos * kInvFreq[i]; const double k = __builtin_rint(a * 0.15915494309189535); const float r = (float)(a - k * 6.283185307179586);
        *(f32x2*)(rope + (size_t)e * 2) = (f32x2){__cosf(r), __sinf(r)};
    }
    { unsigned* z = (unsigned*)(P.ws + WS_SSQ); for (int e = gt; e < M + 68 * 64; e += NGT) z[e] = 0u; }
    constexpr int NV = DB * (WIN - DS) * (KVW / 4);
    for (int e = gt; e < 2 * NV; e += NGT) {
        const int which = e >= NV; const int r = which ? e - NV : e; const int db = r / ((WIN - DS) * (KVW / 4)), q = r % ((WIN - DS) * (KVW / 4));
        const f32x4* src = (const f32x4*)(which ? P.cv : P.ck) + (size_t)db * WIN * (KVW / 4) + DS * (KVW / 4) + q;
        f32x4* dst = (f32x4*)(P.out + (which ? O_VWS : O_KWS)) + (size_t)db * WIN * (KVW / 4) + q;
        *dst = *src;
    }
}

constexpr int KS_STRIDE = 72, VT_STRIDE = 264;
constexpr int A_STRIDE = 136;
template <int NKT, int MODE>
__device__ __forceinline__ void attn_qtile(const bf16_t* qp, LAS const unsigned char* Ks, LAS const unsigned char* VTs, int lane, int qt, bool first, float sink2,
                                           bf16_t* op, const bf16_t* zp) {
    const int n = lane & 15, quad = lane >> 4;
    const bf16x8 qf0 = *(const bf16x8*)(qp + quad * 8), qf1 = *(const bf16x8*)(qp + 32 + quad * 8);
    f32x4 s[NKT];
    const int qi = (MODE == 0) ? qt * 16 + n : (n & 7);
#pragma unroll
    for (int kt = 0; kt < NKT; ++kt) {
        bool need;
        if (MODE == 0) need = (kt < 8) ? (!first && kt >= qt) : (kt - 8 <= qt); else need = kt < 9;
        s[kt] = (f32x4){-1e30f, -1e30f, -1e30f, -1e30f};
        if (need) {
            const LAS unsigned char* kp = Ks + (kt * 16 + n) * (KS_STRIDE * 2) + quad * 16;
            const bf16x8 k0 = *(const LAS bf16x8*)kp, k1 = *(const LAS bf16x8*)(kp + 64);
            f32x4 c = {0.f, 0.f, 0.f, 0.f};
            c = __builtin_amdgcn_mfma_f32_16x16x32_bf16(k0, qf0, c, 0, 0, 0);
            c = __builtin_amdgcn_mfma_f32_16x16x32_bf16(k1, qf1, c, 0, 0, 0);
#pragma unroll
            for (int j = 0; j < 4; ++j) { const int kk = kt * 16 + quad * 4 + j; bool vis;
                if (MODE == 0) vis = (kk < 128) ? (kk > qi) : (kk - 128 <= qi); else vis = (kk < 128) ? (kk > qi) : (kk - 128 <= qi);
                s[kt][j] = vis ? c[j] : -1e30f; }
        }
    }
    float mx = -1e30f;
#pragma unroll
    for (int kt = 0; kt < NKT; ++kt) mx = fmaxf(mx, fmaxf(fmaxf(s[kt][0], s[kt][1]), fmaxf(s[kt][2], s[kt][3])));
    mx = fmaxf(mx, __shfl_xor(mx, 16)); mx = fmaxf(mx, __shfl_xor(mx, 32)); mx = fmaxf(mx, sink2);
    float sum = 0.f;
#pragma unroll
    for (int kt = 0; kt < NKT; ++kt) {
#pragma unroll
        for (int j = 0; j < 4; ++j) { const float p = __builtin_amdgcn_exp2f(s[kt][j] - mx); s[kt][j] = p; sum += p; } }
    sum += __shfl_xor(sum, 16); sum += __shfl_xor(sum, 32); sum += __builtin_amdgcn_exp2f(sink2 - mx);
    const float inv = 1.0f / sum;
    f32x4 o[4];
#pragma unroll
    for (int dt = 0; dt < 4; ++dt) o[dt] = (f32x4){0.f, 0.f, 0.f, 0.f};
#pragma unroll
    for (int pp = 0; pp < NKT / 2; ++pp) {
        bool need;
        if (MODE == 0) need = (pp < 4) ? (!first && 2 * pp + 1 >= qt) : (2 * pp - 8 <= qt); else need = pp < 5;
        if (need) {
            u32x4 pw; pw.x = pk2(s[2 * pp][0], s[2 * pp][1]); pw.y = pk2(s[2 * pp][2], s[2 * pp][3]); pw.z = pk2(s[2 * pp + 1][0], s[2 * pp + 1][1]); pw.w = pk2(s[2 * pp + 1][2], s[2 * pp + 1][3]);
            const bf16x8 pf = __builtin_bit_cast(bf16x8, pw);
#pragma unroll
            for (int dt = 0; dt < 4; ++dt) {
                const LAS unsigned char* vp = VTs + (dt * 16 + n) * (VT_STRIDE * 2) + (pp * 32 + quad * 4) * 2;
                const u32x2 v0 = *(const LAS u32x2*)vp, v1 = *(const LAS u32x2*)(vp + 32);
                const u32x4 vw = {v0.x, v0.y, v1.x, v1.y};
                o[dt] = __builtin_amdgcn_mfma_f32_16x16x32_bf16(__builtin_bit_cast(bf16x8, vw), pf, o[dt], 0, 0, 0);
            }
        }
    }
#pragma unroll
    for (int dt = 0; dt < 4; ++dt) {
        const u32x2 zw = *(const u32x2*)(zp + dt * 16 + quad * 4);
        const f32x4 z = {pg8::bf_lo(zw.x), pg8::bf_hi(zw.x), pg8::bf_lo(zw.y), pg8::bf_hi(zw.y)};
        const f32x4 r = o[dt] * inv * z; u32x2 w; w.x = pk2(r[0], r[1]); w.y = pk2(r[2], r[3]);
        *(u32x2*)(op + dt * 16 + quad * 4) = w;
    }
}
__device__ __forceinline__ void p2_mixers(const Ptrs& P, LAS unsigned char* lds, int vcu, int G, int wave, int lane, int tid) {
    bf16_t* Z1 = (bf16_t*)(P.ws + WS_Z1); bf16_t* AB = (bf16_t*)(P.ws + WS_H); const float* stats = (const float*)(P.ws + WS_STATS);
    {
        LAS unsigned char* vnT = lds; LAS unsigned char* Wl = lds + 128 * A_STRIDE * 2; LAS float* mr = (LAS float*)(lds + 2 * 128 * A_STRIDE * 2);
        for (int un = vcu; un < (MP / CH) * NG; un += G) {
            const int ci = un >> 3, g = un & 7, row0 = ci * CH;
            if (tid < CH) {
                const f32x4* sp = (const f32x4*)(stats + (size_t)(row0 + tid) * 32); float s = 0.f, q = 0.f;
#pragma unroll
                for (int j = 0; j < 8; ++j) { const f32x4 v = sp[j]; s += v[0] + v[2]; q += v[1] + v[3]; }
                const float mean = s * (1.0f / AW), var = q * (1.0f / AW) - mean * mean;
                mr[tid * 2] = mean; mr[tid * 2 + 1] = 1.0f / sqrtf(fmaxf(var, 0.f) + EPS);
            }
#pragma unroll
            for (int i = 0; i < 8; ++i) { const int e = tid + i * NTHR, t = e >> 5, s0 = (e & 31) * 4;
                const f32x4 w = *(const f32x4*)(P.w_sp + ((size_t)g * CH + t) * CH + s0);
                u32x2 o; o.x = pk2(s0 <= t ? w[0] : 0.f, s0 + 1 <= t ? w[1] : 0.f); o.y = pk2(s0 + 2 <= t ? w[2] : 0.f, s0 + 3 <= t ? w[3] : 0.f);
                *(LAS u32x2*)(Wl + t * (A_STRIDE * 2) + s0 * 2) = o; }
            __syncthreads();
#pragma unroll
            for (int i = 0; i < 4; ++i) { const int e = tid + i * NTHR, s = e >> 4, c0 = (e & 15) * 8;
                f32x4 a, b; unpack8(*(const u32x4*)(Z1 + (size_t)(row0 + s) * Z1W + C_V + g * CH + c0), a, b);
                const float mean = mr[s * 2], rstd = mr[s * 2 + 1];
                const f32x4 g0 = *(const f32x4*)(P.ln_g + g * CH + c0), g1 = *(const f32x4*)(P.ln_g + g * CH + c0 + 4), b0 = *(const f32x4*)(P.ln_b + g * CH + c0), b1 = *(const f32x4*)(P.ln_b + g * CH + c0 + 4);
                a = (a - mean) * rstd * g0 + b0; b = (b - mean) * rstd * g1 + b1;
#pragma unroll
                for (int j = 0; j < 4; ++j) { *(LAS bf16_t*)(vnT + (c0 + j) * (A_STRIDE * 2) + s * 2) = (bf16_t)f2bf(a[j]); *(LAS bf16_t*)(vnT + (c0 + 4 + j) * (A_STRIDE * 2) + s * 2) = (bf16_t)f2bf(b[j]); } }
            __syncthreads();
            {
                const int n = lane & 15, quad = lane >> 4, t = wave * 16 + n; const int nks = (wave >> 1) + 1;
                f32x4 acc[8];
#pragma unroll
                for (int ct = 0; ct < 8; ++ct) acc[ct] = (f32x4){0.f, 0.f, 0.f, 0.f};
                for (int ks = 0; ks < nks; ++ks) {
                    const bf16x8 wf = *(const LAS bf16x8*)(Wl + t * (A_STRIDE * 2) + (ks * 32 + quad * 8) * 2);
#pragma unroll
                    for (int ct = 0; ct < 8; ++ct) { const bf16x8 vf = *(const LAS bf16x8*)(vnT + (ct * 16 + n) * (A_STRIDE * 2) + (ks * 32 + quad * 8) * 2);
                        acc[ct] = __builtin_amdgcn_mfma_f32_16x16x32_bf16(vf, wf, acc[ct], 0, 0, 0); }
                }
                const int row = row0 + t; const float bs = P.b_sp[g * CH + t];
#pragma unroll
                for (int ct = 0; ct < 8; ++ct) { const int col = g * CH + ct * 16 + quad * 4;
                    const u32x2 uw = *(const u32x2*)(Z1 + (size_t)row * Z1W + C_U + col), zw = *(const u32x2*)(Z1 + (size_t)row * Z1W + C_ZA + col);
                    const f32x4 uu = {pg8::bf_lo(uw.x), pg8::bf_hi(uw.x), pg8::bf_lo(uw.y), pg8::bf_hi(uw.y)}, zz = {pg8::bf_lo(zw.x), pg8::bf_hi(zw.x), pg8::bf_lo(zw.y), pg8::bf_hi(zw.y)};
                    const f32x4 r = uu * (acc[ct] + bs) * zz; u32x2 w; w.x = pk2(r[0], r[1]); w.y = pk2(r[2], r[3]);
                    *(u32x2*)(AB + (size_t)row * 2048 + col) = w; }
            }
            __syncthreads();
        }
    }
    {
        LAS float* mr = (LAS float*)lds;
        for (int db = vcu; db < DB; db += G) {
            const int row0 = MP + db * DS;
            if (tid < DS) {
                const f32x4* sp = (const f32x4*)(stats + (size_t)(row0 + tid) * 32); float s = 0.f, q = 0.f;
#pragma unroll
                for (int j = 0; j < 8; ++j) { const f32x4 v = sp[j]; s += v[0] + v[2]; q += v[1] + v[3]; }
                const float mean = s * (1.0f / AW), var = q * (1.0f / AW) - mean * mean;
                mr[tid * 2] = mean; mr[tid * 2 + 1] = 1.0f / sqrtf(fmaxf(var, 0.f) + EPS);
            }
            __syncthreads();
            const int c = tid * 2, g = c >> 7;
            const f32x2 lg = *(const f32x2*)(P.ln_g + c), lb = *(const f32x2*)(P.ln_b + c);
            f32x2 vn[DS];
#pragma unroll
            for (int s = 0; s < DS; ++s) { const unsigned w = *(const unsigned*)(Z1 + (size_t)(row0 + s) * Z1W + C_V + c);
                const float mean = mr[s * 2], rstd = mr[s * 2 + 1];
                vn[s] = (f32x2){(pg8::bf_lo(w) - mean) * rstd * lg.x + lb.x, (pg8::bf_hi(w) - mean) * rstd * lg.y + lb.y};
                *(f32x2*)(P.out + O_CV + (size_t)(db * DS + s) * AW + c) = vn[s]; }
#pragma unroll
            for (int t = 0; t < DS; ++t) {
                const float bs = P.b_sp[g * CH + t]; f32x2 acc = {bs, bs};
#pragma unroll
                for (int s = 0; s <= t; ++s) { const float w = P.w_sp[((size_t)g * CH + t) * CH + s]; acc += vn[s] * w; }
                const unsigned uw = *(const unsigned*)(Z1 + (size_t)(row0 + t) * Z1W + C_U + c), zw = *(const unsigned*)(Z1 + (size_t)(row0 + t) * Z1W + C_ZA + c);
                *(unsigned*)(AB + (size_t)(row0 + t) * 2048 + c) = pk2(pg8::bf_lo(uw) * acc.x * pg8::bf_lo(zw), pg8::bf_hi(uw) * acc.y * pg8::bf_hi(zw));
            }
            __syncthreads();
        }
    }
    LAS unsigned char* Ks = lds; LAS unsigned char* VTs = lds + 256 * KS_STRIDE * 2;
    for (int un = vcu; un < NB * NKV * (SEQ / WIN); un += G) {
        const int blk = un & 15, kvh = (un >> 4) & 3, b = un >> 6; const bool first = blk == 0;
        const int krow0 = b * SEQ + (blk - 1) * WIN;
#pragma unroll
        for (int i = 0; i < 4; ++i) { const int e = tid + i * NTHR, key = e >> 3, c8 = (e & 7) * 8;
            if (!(first && key < WIN)) {
                const size_t zr = (size_t)(krow0 + key) * Z1W;
                const u32x4 kw = *(const u32x4*)(Z1 + zr + C_K + kvh * HD + c8);
                *(LAS u32x4*)(Ks + key * (KS_STRIDE * 2) + c8 * 2) = kw;
                const u32x4 vw = *(const u32x4*)(Z1 + zr + C_VA + kvh * HD + c8);
                LAS unsigned char* vt = VTs + c8 * (VT_STRIDE * 2) + key * 2;
                *(LAS bf16_t*)(vt + 0 * VT_STRIDE * 2) = (bf16_t)(vw.x & 0xffff); *(LAS bf16_t*)(vt + 1 * VT_STRIDE * 2) = (bf16_t)(vw.x >> 16);
                *(LAS bf16_t*)(vt + 2 * VT_STRIDE * 2) = (bf16_t)(vw.y & 0xffff); *(LAS bf16_t*)(vt + 3 * VT_STRIDE * 2) = (bf16_t)(vw.y >> 16);
                *(LAS bf16_t*)(vt + 4 * VT_STRIDE * 2) = (bf16_t)(vw.z & 0xffff); *(LAS bf16_t*)(vt + 5 * VT_STRIDE * 2) = (bf16_t)(vw.z >> 16);
                *(LAS bf16_t*)(vt + 6 * VT_STRIDE * 2) = (bf16_t)(vw.w & 0xffff); *(LAS bf16_t*)(vt + 7 * VT_STRIDE * 2) = (bf16_t)(vw.w >> 16);
            } }
        __syncthreads();
        {
            const int head = kvh * 4 + (wave >> 1); const float sink2 = P.sinks[head] * LOG2E;
            for (int q4 = 0; q4 < 4; ++q4) {
                const int qt = (wave & 1) * 4 + q4; const int row = b * SEQ + blk * WIN + qt * 16 + (lane & 15);
                attn_qtile<16, 0>(Z1 + (size_t)row * Z1W + C_Q + head * HD, Ks, VTs, lane, qt, first, sink2, AB + (size_t)row * 2048 + AW + head * HD, Z1 + (size_t)row * Z1W + C_ZB + head * HD);
            }
        }
        __syncthreads();
    }
    for (int un = vcu; un < DB * NKV; un += G) {
        const int kvh = un & 3, db = un >> 2; const int row0 = MP + db * DS;
#pragma unroll
        for (int i = 0; i < 4; ++i) { const int e = tid + i * NTHR, key = e >> 4, d0 = (e & 15) * 4;
            const size_t src = ((size_t)(db * WIN + key) * NKV + kvh) * HD + d0;
            const f32x4 kv = *(const f32x4*)(P.ck + src); const f32x4 vv = *(const f32x4*)(P.cv + src);
            const int i0 = d0 & 31, eo = d0 >> 5;
#pragma unroll
            for (int j = 0; j < 4; ++j) { *(LAS bf16_t*)(Ks + key * (KS_STRIDE * 2) + (2 * (i0 + j) + eo) * 2) = (bf16_t)f2bf(kv[j]);
                                          *(LAS bf16_t*)(VTs + (d0 + j) * (VT_STRIDE * 2) + key * 2) = (bf16_t)f2bf(vv[j]); } }
        if (tid < 32 * 8) { const int key = 128 + (tid >> 3), c8 = (tid & 7) * 8; u32x4 kw = {0u, 0u, 0u, 0u}, vw = {0u, 0u, 0u, 0u};
            if (key < 128 + DS) { const size_t zr = (size_t)(row0 + key - 128) * Z1W; kw = *(const u32x4*)(Z1 + zr + C_K + kvh * HD + c8); vw = *(const u32x4*)(Z1 + zr + C_VA + kvh * HD + c8); }
            *(LAS u32x4*)(Ks + key * (KS_STRIDE * 2) + c8 * 2) = kw;
            LAS unsigned char* vt = VTs + c8 * (VT_STRIDE * 2) + key * 2;
            *(LAS bf16_t*)(vt + 0 * VT_STRIDE * 2) = (bf16_t)(vw.x & 0xffff); *(LAS bf16_t*)(vt + 1 * VT_STRIDE * 2) = (bf16_t)(vw.x >> 16);
            *(LAS bf16_t*)(vt + 2 * VT_STRIDE * 2) = (bf16_t)(vw.y & 0xffff); *(LAS bf16_t*)(vt + 3 * VT_STRIDE * 2) = (bf16_t)(vw.y >> 16);
            *(LAS bf16_t*)(vt + 4 * VT_STRIDE * 2) = (bf16_t)(vw.z & 0xffff); *(LAS bf16_t*)(vt + 5 * VT_STRIDE * 2) = (bf16_t)(vw.z >> 16);
            *(LAS bf16_t*)(vt + 6 * VT_STRIDE * 2) = (bf16_t)(vw.w & 0xffff); *(LAS bf16_t*)(vt + 7 * VT_STRIDE * 2) = (bf16_t)(vw.w >> 16);
        }
        __syncthreads();
        if (wave < 2) {
            const int n = lane & 15; const int head = kvh * 4 + wave * 2 + (n >> 3); const int row = row0 + (n & 7);
            attn_qtile<10, 1>(Z1 + (size_t)row * Z1W + C_Q + head * HD, Ks, VTs, lane, 0, false, P.sinks[head] * LOG2E, AB + (size_t)row * 2048 + AW + head * HD, Z1 + (size_t)row * Z1W + C_ZB + head * HD);
        }
        __syncthreads();
    }
}

struct Args { Ptrs p; int ph_lo, ph_hi; };
typedef const __attribute__((address_space(4))) Args* KArgPtr;
__device__ __forceinline__ Ptrs load_ptrs() {
    KArgPtr ap = (KArgPtr)__builtin_amdgcn_kernarg_segment_ptr(); asm volatile("" : "+s"(ap));
    Ptrs P; P.xp = ap->p.xp; P.xs = ap->p.xs; P.ck = ap->p.ck; P.cv = ap->p.cv; P.g_pre = ap->p.g_pre; P.w_in = ap->p.w_in; P.ln_g = ap->p.ln_g; P.ln_b = ap->p.ln_b;
    P.w_sp = ap->p.w_sp; P.b_sp = ap->p.b_sp; P.sinks = ap->p.sinks; P.w_pa = ap->p.w_pa; P.w_pb = ap->p.w_pb; P.w_out = ap->p.w_out; P.g_post = ap->p.g_post; P.out = ap->p.out; P.ws = ap->p.ws;
    return P;
}
__global__ void __launch_bounds__(NTHR, 2) fwd_kernel(Args args) {
    extern __shared__ __attribute__((aligned(16))) unsigned char lds_raw[];
    LAS unsigned char* lds = (LAS unsigned char*)lds_raw;
    const int tid = threadIdx.x, lane = tid & 63, wave = __builtin_amdgcn_readfirstlane(tid >> 6);
    const int G = gridDim.x, bx = blockIdx.x; const int vcu = (G % 8 == 0) ? (bx % 8) * (G / 8) + bx / 8 : bx;
    const int lo = args.ph_lo, hi = args.ph_hi;
#ifndef PH_MASK
#define PH_MASK 63
#endif
#define IN(k) (((PH_MASK >> (k)) & 1) && lo <= (k) && (k) < hi)
#ifndef DUP_MASK
#define DUP_MASK 0
#endif
#define REP(k) for (int rep_ = 0; rep_ < (((DUP_MASK >> (k)) & 1) ? 2 : 1); ++rep_)
#define SEAM(k) do { if (IN(k) && IN((k) + 1)) xcd_barrier(bar); } while (0)
    if (lo == -12345) cg::this_grid().sync();
    volatile LAS unsigned* st = (volatile LAS unsigned*)(lds + 131072 + 64);
    if (tid < 2) st[tid] = 0u;
    __syncthreads();
    XcdBarrier bar; bar.bar = nullptr; bar.x = 0; bar.st = nullptr;
    if (hi - lo > 1) { KArgPtr ap0 = (KArgPtr)__builtin_amdgcn_kernarg_segment_ptr(); bar = xcd_barrier_post((unsigned*)(ap0->p.ws + WS_CTL), st); }
    if (IN(0)) REP(0) { const Ptrs P = load_ptrs(); p0_prologue(P, lds, vcu, G, wave, lane, tid); __syncthreads(); }
    SEAM(0);
    if (IN(1)) REP(1) {
        const Ptrs P = load_ptrs();
        bf16_t* WinT = (bf16_t*)(P.ws + WS_WIN); bf16_t* H = (bf16_t*)(P.ws + WS_H);
        pg8::Gemm g; g.A0 = H; g.A1 = H; g.Bt0 = WinT; g.Bt1 = WinT; g.K = DM;
        pg8::StaticOrder S; S.init(M, INC, G, bx, 1);
        EpiIn E{(bf16_t*)(P.ws + WS_Z1), (bf16_t*)(P.ws + WS_G), (float*)(P.ws + WS_STATS), (const float*)(P.ws + WS_ROPE), P.out};
        pg8::gemm_phase<EpiIn, pg8::StaticOrder, true, true>(lds, g, S, E);
    }
    SEAM(1);
    if (IN(2)) REP(2) { const Ptrs P = load_ptrs(); p2_mixers(P, lds, vcu, G, wave, lane, tid); }
    SEAM(2);
    if (IN(3)) REP(3) {
        const Ptrs P = load_ptrs();
        bf16_t* WpT = (bf16_t*)(P.ws + WS_WP); bf16_t* H = (bf16_t*)(P.ws + WS_H);
        pg8::Gemm g; g.A0 = H; g.A1 = H + AW; g.Bt0 = WpT; g.Bt1 = WpT + AW; g.K = AW;
        pg8::StaticOrder S; S.init(M, DM, G, bx, 2);
        EpiMerge E{(const bf16_t*)(P.ws + WS_G), (bf16_t*)(P.ws + WS_Z1)};
        pg8::gemm_phase<EpiMerge, pg8::StaticOrder, true, true>(lds, g, S, E);
    }
    SEAM(3);
    if (IN(4)) {
        const Ptrs P = load_ptrs();
        bf16_t* WoutT = (bf16_t*)(P.ws + WS_WOUT); bf16_t* MG = (bf16_t*)(P.ws + WS_Z1);
        pg8::Gemm g; g.A0 = MG; g.A1 = MG; g.Bt0 = WoutT; g.Bt1 = WoutT; g.K = DM;
        PanelOrder S; S.init(M, G, vcu);
        EpiOutNorm E{P.xp, P.xs, P.g_post, P.out + O_Y, (float*)(P.ws + WS_SSQ), (unsigned*)(P.ws + WS_SSQ + (size_t)M * 4)};
        pg8::gemm_phase<EpiOutNorm, PanelOrder, true, true>(lds, g, S, E);
    }
#undef IN
#undef SEAM
}

extern "C" void kernel_launch(void* const* d_in, const int* in_sizes, int n_in, void* d_out, int out_size, void* d_ws, size_t ws_size, hipStream_t stream) {
    static int grid = 0;
    if (grid == 0) {
        if (n_in != 15 || in_sizes[0] != MP * DM || (size_t)out_size != O_END || ws_size < WS_END) {
            fprintf(stderr, "kernel_launch: unexpected shapes (n_in %d, in0 %d, out %d, ws %zu, need %zu)\n", n_in, n_in > 0 ? in_sizes[0] : -1, out_size, ws_size, (size_t)WS_END); grid = -1; return; }
        if (hipFuncSetAttribute((const void*)fwd_kernel, hipFuncAttributeMaxDynamicSharedMemorySize, LDS_BYTES) != hipSuccess) { fprintf(stderr, "kernel_launch: hipFuncSetAttribute failed\n"); grid = -1; return; }
        int dev = 0, cus = 0, per_cu = 0;
        hipGetDevice(&dev); hipDeviceGetAttribute(&cus, hipDeviceAttributeMultiprocessorCount, dev);
        hipOccupancyMaxActiveBlocksPerMultiprocessor(&per_cu, (const void*)fwd_kernel, NTHR, LDS_BYTES);
        if (per_cu < 1) { fprintf(stderr, "kernel_launch: occupancy query says %d blocks per CU\n", per_cu); per_cu = 1; }
        (void)hipGetLastError();
        grid = cus;
    }
    if (grid < 0) return;
    if (hipMemsetAsync((char*)d_ws + WS_CTL, 0, CTL_ZERO_BYTES, stream) != hipSuccess) { fprintf(stderr, "kernel_launch: hipMemsetAsync failed\n"); return; }
    Args a{};
    a.p.xp = (const float*)d_in[0]; a.p.xs = (const float*)d_in[1]; a.p.ck = (const float*)d_in[2]; a.p.cv = (const float*)d_in[3]; a.p.g_pre = (const float*)d_in[4];
    a.p.w_in = (const float*)d_in[5]; a.p.ln_g = (const float*)d_in[6]; a.p.ln_b = (const float*)d_in[7]; a.p.w_sp = (const float*)d_in[8]; a.p.b_sp = (const float*)d_in[9];
    a.p.sinks = (const float*)d_in[10]; a.p.w_pa = (const float*)d_in[11]; a.p.w_pb = (const float*)d_in[12]; a.p.w_out = (const float*)d_in[13]; a.p.g_post = (const float*)d_in[14];
    a.p.out = (float*)d_out; a.p.ws = (unsigned char*)d_ws;
#if MK_N_LAUNCHES == 1
    a.ph_lo = 0; a.ph_hi = 5;
    void* kargs[] = {&a};
    hipError_t e = hipLaunchCooperativeKernel((const void*)fwd_kernel, dim3(grid), dim3(NTHR), kargs, LDS_BYTES, stream);
    if (e != hipSuccess) fprintf(stderr, "kernel_launch: cooperative launch failed: %s (grid %d)\n", hipGetErrorString(e), grid);
#else
    for (int ph = 0; ph < 5; ++ph) { a.ph_lo = ph; a.ph_hi = ph + 1; hipLaunchKernelGGL(fwd_kernel, dim3(grid), dim3(NTHR), LDS_BYTES, stream, a); }
#endif
}
```

```cpp
#include <hip/hip_runtime.h>
#include <hip/hip_cooperative_groups.h>
#include <cstdio>
#include <cstdint>
namespace cg = cooperative_groups;

#ifndef MK_N_LAUNCHES
#define MK_N_LAUNCHES 1
#endif

namespace pg8 {
#define PG8_LAS __attribute__((address_space(3)))
typedef unsigned short bf16_t;
typedef short bf16x8 __attribute__((ext_vector_type(8)));
typedef float f32x4 __attribute__((ext_vector_type(4)));
typedef float f32x2 __attribute__((ext_vector_type(2)));
typedef unsigned u32x4 __attribute__((ext_vector_type(4)));
typedef unsigned u32x2 __attribute__((ext_vector_type(2)));
constexpr int BM = 256, BK = 64, HALF = 128, HTB = HALF * BK * 2  , STAGE_BYTES = 8 * HTB, NXCD = 8, WGM = 8;

__host__ __device__ __forceinline__ int lds_byte(int r, int c) { const int st = (r >> 4) * 2 + (c >> 5), rr = r & 15, cc = c & 31, ob = rr * 64 + cc * 2; return st * 1024 + (ob ^ (((ob >> 9) & 1) << 5)); }
__host__ __device__ __forceinline__ void stage_rc(int b, int& R, int& C) { const int st = b / 1024, sb = b % 1024, swz = sb ^ (((sb >> 9) & 1) << 5); R = (st >> 1) * 16 + swz / 64; C = (st & 1) * 32 + (swz % 64) / 2; }
__host__ __device__ __forceinline__ int perm32(int rho) { const int n = rho >> 4, i = rho & 15; return 8 * (i >> 2) + 4 * n + (i & 3); }

struct Unit { int pm, pn, kh, ty; };
constexpr size_t TSTEP = (size_t)256 * 2048 * 2;

struct StaticOrder {
    int nM, nN, nwg, G, c, nkh; const bf16_t *A0, *A1, *Bt0, *Bt1; int ntile;
    __device__ void init(int M, int N, int G_, int c_, int nkh_) { nM = M / BM; nN = N / BM; nwg = nM * nN; G = G_; c = c_; nkh = nkh_; }
    __device__ bool next(int i, Unit& u) const {
        const int ti = (nkh == 2) ? (i >> 1) : i; u.kh = (nkh == 2) ? (i & 1) : 0; u.ty = 0;
        const long L = (long)ti * G + c; if (L >= nwg) return false;
        int wgid = (int)L; { const int q = nwg / NXCD, r = nwg % NXCD, xcd = wgid % NXCD, off = wgid / NXCD; wgid = (xcd < r ? xcd * (q + 1) : r * (q + 1) + (xcd - r) * q) + off; }
        const int nig = WGM * nN, gid = wgid / nig, fm = gid * WGM, gsz = (nM - fm) < WGM ? (nM - fm) : WGM;
        u.pm = fm + ((wgid % nig) % gsz); u.pn = (wgid % nig) / gsz; return true;
    }
    __device__ __forceinline__ void operands(const Unit& u, const char*& A, const char*& B, int& nt) const {
        A = (const char*)(u.kh ? A1 : A0) + (size_t)u.pm * TSTEP; B = (const char*)(u.kh ? Bt1 : Bt0) + (size_t)u.pn * TSTEP; nt = ntile; }
    __device__ __forceinline__ void a_ready(const Unit&) const {}
    __device__ __forceinline__ void done(const Unit&) const {}
};

__device__ __forceinline__ unsigned cvt_pk_bf16(float lo, float hi) { unsigned r; asm volatile("v_cvt_pk_bf16_f32 %0, %1, %2" : "=v"(r) : "v"(lo), "v"(hi)); return r; }
__device__ __forceinline__ u32x4 pack8(f32x4 a, f32x4 b) { u32x4 w; w.x = cvt_pk_bf16(a[0], a[1]); w.y = cvt_pk_bf16(a[2], a[3]); w.z = cvt_pk_bf16(b[0], b[1]); w.w = cvt_pk_bf16(b[2], b[3]); return w; }
__device__ __forceinline__ float bf_lo(unsigned w) { return __uint_as_float(w << 16); }
__device__ __forceinline__ float bf_hi(unsigned w) { return __uint_as_float(w & 0xffff0000u); }
__device__ __forceinline__ f32x2 gelu_pk(f32x2 v) {
    const f32x2 av = __builtin_elementwise_abs(v), d = av * 0.2316418882f + 1.0f;
    f32x2 t; t.x = __builtin_amdgcn_rcpf(d.x); t.y = __builtin_amdgcn_rcpf(d.y);
    f32x2 q = t * 0.5307027145f + (-0.7265760135f); q = q * t + 0.7107068705f; q = q * t + (-0.142248368f); q = q * t + 0.127414796f; q = q * t;
    const f32x2 s = (v * v) * (-0.72134752044f);
    f32x2 e; e.x = __builtin_amdgcn_exp2f(s.x); e.y = __builtin_amdgcn_exp2f(s.y);
    const f32x2 m = v * (q * e), r = v - m;
    f32x2 o; o.x = v.x < 0.f ? m.x : r.x; o.y = v.y < 0.f ? m.y : r.y; return o;
}
__device__ __forceinline__ f32x4 gelu4(f32x4 v) { const f32x2 a = gelu_pk((f32x2){v[0], v[1]}), b = gelu_pk((f32x2){v[2], v[3]}); return (f32x4){a.x, a.y, b.x, b.y}; }
__device__ __forceinline__ float sigm(float x) { return __builtin_amdgcn_rcpf(1.0f + __builtin_amdgcn_exp2f(-1.4426950408889634f * x)); }
__device__ __forceinline__ f32x4 sigm4(f32x4 v) { return (f32x4){sigm(v[0]), sigm(v[1]), sigm(v[2]), sigm(v[3])}; }
__device__ __forceinline__ f32x4 silu4(f32x4 v) { return v * sigm4(v); }

template <class Epi, class Sched, bool ALIGN_EPI = false, bool SP2 = false>
__device__ __forceinline__ void gemm_phase(PG8_LAS unsigned char* lds, const Sched& S, const Epi& E) {
    const int tid = threadIdx.x, wid = __builtin_amdgcn_readfirstlane(tid >> 6), lane = tid & 63, wr = wid >> 2, wc = wid & 3, fr = lane & 15, fq = lane >> 4;
    int nt = 0; constexpr int lda = 2048, ldb = 2048;
    unsigned voffA[2], voffB[2];
#pragma unroll
    for (int i = 0; i < 2; ++i) { int R, C; stage_rc(tid * 16 + i * 8192, R, C); const int Rb = Epi::PERM ? ((R & ~31) + perm32(R & 31)) : R;
        voffA[i] = (unsigned)(R * lda + C) * 2u; voffB[i] = (unsigned)(Rb * ldb + C) * 2u; }
    const size_t kstep = (size_t)(BK * 2);
    const size_t hstepA = (size_t)HALF * lda * 2, hstepB = (size_t)HALF * ldb * 2;
    const size_t tstepA = 2 * hstepA, tstepB = 2 * hstepB;
    const unsigned ldsw = (unsigned)wid * 1024u;
    const int aoff = lds_byte(wr * 64 + fr, fq * 8), boff = lds_byte(wc * 32 + fr, fq * 8);
#define PG8_SA(b, h) (((b) * 2 + (h)) * HTB)
#define PG8_SB(b, h) ((4 + (b) * 2 + (h)) * HTB)
#define PG8_STAGE(bufoff, gbase, voff) do { _Pragma("unroll") for (int _i = 0; _i < 2; ++_i) \
        __builtin_amdgcn_global_load_lds((const unsigned*)((const char*)(gbase) + (voff)[_i]), (PG8_LAS unsigned*)(lds + (bufoff) + ldsw + _i * 8192), 16, 0, 0); } while (0)
#define PG8_LDA(dst, b, h) do { _Pragma("unroll") for (int m = 0; m < 4; ++m) _Pragma("unroll") for (int k = 0; k < 2; ++k) dst[m][k] = *(const PG8_LAS bf16x8*)(lds + PG8_SA(b, h) + aoff + m * 2048 + k * 1024); } while (0)
#define PG8_LDB(dst, b, h) do { _Pragma("unroll") for (int n = 0; n < 2; ++n) _Pragma("unroll") for (int k = 0; k < 2; ++k) dst[n][k] = *(const PG8_LAS bf16x8*)(lds + PG8_SB(b, h) + boff + n * 2048 + k * 1024); } while (0)
#define PG8_MMA(ai, bj, At, Bt) do { __builtin_amdgcn_s_setprio(1); _Pragma("unroll") for (int m = 0; m < 4; ++m) _Pragma("unroll") for (int n = 0; n < 2; ++n) _Pragma("unroll") for (int k = 0; k < 2; ++k) \
        acc[ai][bj][m][n] = __builtin_amdgcn_mfma_f32_16x16x32_bf16(Bt[n][k], At[m][k], acc[ai][bj][m][n], 0, 0, 0); __builtin_amdgcn_s_setprio(0); } while (0)
#define PG8_WAIT_V(n) asm volatile("s_waitcnt vmcnt(" #n ")" ::: "memory")
#define PG8_WAIT_L(n) asm volatile("s_waitcnt lgkmcnt(" #n ")" ::: "memory")
#define PG8_BAR __builtin_amdgcn_s_barrier()
#define PG8_SCHED __builtin_amdgcn_sched_barrier(0)
    Unit cur, nxt; int ui = 0;
    if (!S.next(0, cur)) return;
    f32x4 acc[2][2][4][2];
#pragma unroll
    for (int a = 0; a < 2; ++a)
#pragma unroll
        for (int b = 0; b < 2; ++b)
#pragma unroll
            for (int m = 0; m < 4; ++m)
#pragma unroll
                for (int n = 0; n < 2; ++n) acc[a][b][m][n] = (f32x4){0.f, 0.f, 0.f, 0.f};
    bf16x8 At[4][2], B0[2][2], B1[2][2];
    const char* cA; const char* cB; S.operands(cur, cA, cB, nt);
    S.a_ready(cur);
    if constexpr (SP2) {
        PG8_STAGE(PG8_SB(0, 0), cB, voffB); PG8_STAGE(PG8_SB(0, 1), cB + hstepB, voffB); PG8_STAGE(PG8_SA(0, 0), cA, voffA); PG8_STAGE(PG8_SA(0, 1), cA + hstepA, voffA);
        if (wr == 1) PG8_BAR;
        PG8_WAIT_V(2); PG8_BAR;
        PG8_STAGE(PG8_SB(1, 0), cB + kstep, voffB); PG8_STAGE(PG8_SA(1, 0), cA + kstep, voffA); PG8_STAGE(PG8_SB(1, 1), cB + hstepB + kstep, voffB);
        PG8_WAIT_V(6); PG8_BAR;
    } else {
        PG8_STAGE(PG8_SB(0, 0), cB, voffB); PG8_STAGE(PG8_SA(0, 0), cA, voffA); PG8_STAGE(PG8_SB(0, 1), cB + hstepB, voffB); PG8_STAGE(PG8_SA(0, 1), cA + hstepA, voffA);
        if (wr == 1) PG8_BAR;
        PG8_WAIT_V(4); PG8_BAR;
        PG8_STAGE(PG8_SB(1, 0), cB + kstep, voffB); PG8_STAGE(PG8_SA(1, 0), cA + kstep, voffA); PG8_STAGE(PG8_SB(1, 1), cB + hstepB + kstep, voffB);
        PG8_WAIT_V(6); PG8_BAR;
    }
    for (;;) {
        const bool has_next = S.next(ui + 1, nxt);
        const char* nA = cA; const char* nB = cB; int nnt = nt; if (has_next) S.operands(nxt, nA, nB, nnt);
        for (int t = 0; t < nt; t += 2) {
            const bool last = (t == nt - 2);
            const char* a1 = cA + (size_t)(t + 1) * kstep;
            const char* a2 = last ? nA : cA + (size_t)(t + 2) * kstep; const char* b2 = last ? nB : cB + (size_t)(t + 2) * kstep;
            const char* a3 = a2 + kstep; const char* b3 = b2 + kstep;
            if (last && has_next) S.a_ready(nxt);
            if constexpr (SP2) {
            PG8_LDB(B0, 0, 0); PG8_LDB(B1, 0, 1); PG8_SCHED; PG8_LDA(At, 0, 0); PG8_STAGE(PG8_SA(1, 1), a1 + hstepA, voffA);
            PG8_WAIT_V(8); PG8_WAIT_L(0); PG8_BAR; PG8_MMA(0, 0, At, B0); PG8_MMA(0, 1, At, B1); PG8_BAR; PG8_SCHED;
            PG8_LDA(At, 0, 1); PG8_STAGE(PG8_SB(0, 0), b2, voffB); PG8_STAGE(PG8_SB(0, 1), b2 + hstepB, voffB); PG8_STAGE(PG8_SA(0, 0), a2, voffA);
            PG8_WAIT_V(8); PG8_WAIT_L(0); PG8_BAR; PG8_MMA(1, 0, At, B0); PG8_MMA(1, 1, At, B1); PG8_BAR; PG8_SCHED;
            PG8_LDB(B0, 1, 0); PG8_LDB(B1, 1, 1); PG8_SCHED; PG8_LDA(At, 1, 0); PG8_STAGE(PG8_SA(0, 1), a2 + hstepA, voffA);
            PG8_WAIT_V(8); PG8_WAIT_L(0); PG8_BAR; PG8_MMA(0, 0, At, B0); PG8_MMA(0, 1, At, B1); PG8_BAR; PG8_SCHED;
            PG8_LDA(At, 1, 1); PG8_STAGE(PG8_SB(1, 0), b3, voffB); PG8_STAGE(PG8_SB(1, 1), b3 + hstepB, voffB); PG8_STAGE(PG8_SA(1, 0), a3, voffA);
            PG8_WAIT_V(8); PG8_WAIT_L(0); PG8_BAR; PG8_MMA(1, 0, At, B0); PG8_MMA(1, 1, At, B1); PG8_BAR; PG8_SCHED;
            } else {
            PG8_LDB(B0, 0, 0); PG8_SCHED; PG8_LDA(At, 0, 0); PG8_STAGE(PG8_SA(1, 1), a1 + hstepA, voffA);
            PG8_WAIT_L(8); PG8_BAR; PG8_WAIT_L(0); PG8_MMA(0, 0, At, B0); PG8_BAR; PG8_SCHED;
            PG8_LDB(B1, 0, 1); PG8_STAGE(PG8_SB(0, 0), b2, voffB);
            PG8_BAR; PG8_WAIT_L(0); PG8_MMA(0, 1, At, B1); PG8_BAR;
            PG8_LDA(At, 0, 1); PG8_STAGE(PG8_SA(0, 0), a2, voffA);
            PG8_BAR; PG8_WAIT_L(0); PG8_MMA(1, 0, At, B0); PG8_BAR; PG8_SCHED;
            PG8_STAGE(PG8_SB(0, 1), b2 + hstepB, voffB);
            PG8_WAIT_V(6); PG8_BAR; PG8_MMA(1, 1, At, B1); PG8_BAR;
            PG8_LDB(B0, 1, 0); PG8_SCHED; PG8_LDA(At, 1, 0); PG8_STAGE(PG8_SA(0, 1), a2 + hstepA, voffA);
            PG8_WAIT_L(8); PG8_BAR; PG8_WAIT_L(0); PG8_MMA(0, 0, At, B0); PG8_BAR; PG8_SCHED;
            PG8_LDB(B1, 1, 1); PG8_STAGE(PG8_SB(1, 0), b3, voffB);
            PG8_BAR; PG8_WAIT_L(0); PG8_MMA(0, 1, At, B1); PG8_BAR;
            PG8_LDA(At, 1, 1); PG8_STAGE(PG8_SA(1, 0), a3, voffA);
            PG8_BAR; PG8_WAIT_L(0); PG8_MMA(1, 0, At, B0); PG8_BAR; PG8_SCHED;
            PG8_STAGE(PG8_SB(1, 1), b3 + hstepB, voffB);
            PG8_WAIT_V(6); PG8_BAR; PG8_MMA(1, 1, At, B1); PG8_BAR;
            }
        }
        if constexpr (ALIGN_EPI) { if (wr == 0) PG8_BAR; }
        if constexpr (!Epi::AFTER_DRAIN) { E(acc, cur, wr, wc, fr, fq); S.done(cur); }
        if (!has_next) break;
        if (Epi::zero_after(cur)) {
#pragma unroll
        for (int a = 0; a < 2; ++a)
#pragma unroll
            for (int b = 0; b < 2; ++b)
#pragma unroll
                for (int m = 0; m < 4; ++m)
#pragma unroll
                    for (int n = 0; n < 2; ++n) acc[a][b][m][n] = (f32x4){0.f, 0.f, 0.f, 0.f};
        }
        cur = nxt; cA = nA; cB = nB; nt = nnt; ++ui;
        if constexpr (ALIGN_EPI) { if (wr == 1) PG8_BAR; }
    }
    PG8_WAIT_V(0);
    if constexpr (!ALIGN_EPI) { if (wr == 0) PG8_BAR; }
    PG8_BAR;
    if constexpr (Epi::AFTER_DRAIN) { E.fused(acc, cur, wr, wc, fr, fq, lds, wid, lane); S.done(cur); }
#undef PG8_SA
#undef PG8_SB
#undef PG8_STAGE
#undef PG8_LDA
#undef PG8_LDB
#undef PG8_MMA
#undef PG8_WAIT_V
#undef PG8_WAIT_L
#undef PG8_BAR
#undef PG8_SCHED
}}

using pg8::bf16_t; using pg8::bf16x8; using pg8::f32x4; using pg8::f32x2; using pg8::u32x4; using pg8::u32x2; using pg8::Unit;
#define LAS __attribute__((address_space(3)))
typedef short s16x4 __attribute__((ext_vector_type(4)));

constexpr int NWAVES = 8, NTHR = 512;
constexpr int DM = 2048, NB = 8, SEQ = 2048, DB = 128, DS = 8, PAST = 8192;
constexpr int MP = NB * SEQ, MS = DB * DS, M = MP + MS;
constexpr int AW = 1024, NG = 8, CH = 128, HD = 64, NH = 16, NKV = 4, BW = 1024, KVW = 256, WIN = 128;
constexpr int INC = 3 * AW + 2 * BW + 2 * KVW + 2 * DM;
constexpr int Z1W = 5632, GW = 4096;
constexpr int C_U = 0, C_V = 1024, C_ZA = 2048, C_Q = 3072, C_K = 4096, C_VA = 4352, C_ZB = 4608;
constexpr float EPS = 1e-6f;
constexpr float QSCALE = 0.125f * 1.4426950408889634f;
constexpr float LOG2E = 1.4426950408889634f;
constexpr int NTPOS = SEQ + DS;

constexpr size_t O_Y = 0, O_KWP = (size_t)M * DM, O_VWP = O_KWP + (size_t)NB * WIN * KVW, O_KWS = O_VWP + (size_t)NB * WIN * KVW,
                 O_VWS = O_KWS + (size_t)DB * WIN * KVW, O_CV = O_VWS + (size_t)DB * WIN * KVW, O_END = O_CV + (size_t)MS * AW;

constexpr size_t al256(size_t x) { return (x + 255) & ~(size_t)255; }
constexpr size_t WS_CTL = 0, CTL_ZERO_BYTES = 16384;
constexpr size_t WS_ROPE = CTL_ZERO_BYTES;
constexpr size_t WS_STATS = al256(WS_ROPE + (size_t)NTPOS * 32 * 2 * 4);
constexpr size_t WS_SSQ = al256(WS_STATS + (size_t)M * 32 * 4);
constexpr size_t WS_WIN = al256(WS_SSQ + (size_t)M * 32 * 4);
constexpr size_t WS_WP = al256(WS_WIN + (size_t)INC * DM * 2);
constexpr size_t WS_WOUT = al256(WS_WP + (size_t)DM * 2048 * 2);
constexpr size_t WS_H = al256(WS_WOUT + (size_t)DM * DM * 2);
constexpr size_t WS_Z1 = al256(WS_H + (size_t)M * DM * 2);
constexpr size_t WS_G = al256(WS_Z1 + (size_t)M * Z1W * 2);
constexpr size_t WS_END = al256(WS_G + (size_t)M * GW * 2);

constexpr int LDS_BYTES = 139264;

enum { T_U = 0, T_V, T_ZA, T_Q, T_K, T_VA, T_ZB, T_G };
struct EpiIn {
    static constexpr bool PERM = true, AFTER_DRAIN = false;
    static __device__ __forceinline__ bool zero_after(const Unit&) { return true; }
    bf16_t* Z1; bf16_t* G; float* stats; const float* rope; float* out;
    template <int TY> __device__ __forceinline__ void tile(f32x4 (&acc)[2][2][4][2], const Unit& u, int wr, int wc, int fr, int fq) const {
        const int cl = wc * 32 + 8 * fq; const int i0 = (16 * wc + 4 * fq) & 31;
        f32x4 rcs[2][4][2];
        if (TY == T_Q || TY == T_K) {
#pragma unroll
            for (int ai = 0; ai < 2; ++ai)
#pragma unroll
                for (int m = 0; m < 4; ++m) { const int row = u.pm * 256 + ai * 128 + wr * 64 + m * 16 + fr;
                    const int tpos = row < MP ? (row & (SEQ - 1)) : SEQ + ((row - MP) & (DS - 1));
                    const f32x4* rp = (const f32x4*)(rope + ((size_t)tpos * 32 + i0) * 2); rcs[ai][m][0] = rp[0]; rcs[ai][m][1] = rp[1]; }
        }
#pragma unroll
        for (int ai = 0; ai < 2; ++ai)
#pragma unroll
            for (int m = 0; m < 4; ++m) {
                const int row = u.pm * 256 + ai * 128 + wr * 64 + m * 16 + fr;
                f32x4 rc0 = {0.f, 0.f, 0.f, 0.f}, rc1 = {0.f, 0.f, 0.f, 0.f};
                if (TY == T_Q || TY == T_K) { rc0 = rcs[ai][m][0]; rc1 = rcs[ai][m][1]; }
                float ss = 0.f, sq = 0.f;
                bool win = false; size_t wbase = 0; float* wk = nullptr;
                if (TY == T_K || TY == T_VA) {
                    if (row < MP) { const int t = row & (SEQ - 1); win = t >= SEQ - WIN; wbase = ((size_t)(row >> 11) * WIN + (t - (SEQ - WIN))) * KVW; wk = out + (TY == T_K ? O_KWP : O_VWP); }
                    else { const int r = row - MP; win = true; wbase = ((size_t)(r >> 3) * WIN + (WIN - DS) + (r & 7)) * KVW; wk = out + (TY == T_K ? O_KWS : O_VWS); }
                }
#pragma unroll
                for (int bj = 0; bj < 2; ++bj) {
                    f32x4 a = acc[ai][bj][m][0], b = acc[ai][bj][m][1];
                    const int col = u.pn * 256 + bj * 128 + cl;
                    if (TY == T_U || TY == T_V) { a = pg8::gelu4(a); b = pg8::gelu4(b); }
                    if (TY == T_V) { ss += (a[0] + a[1]) + (a[2] + a[3]) + (b[0] + b[1]) + (b[2] + b[3]);
                        sq += (a[0] * a[0] + a[1] * a[1]) + (a[2] * a[2] + a[3] * a[3]) + (b[0] * b[0] + b[1] * b[1]) + (b[2] * b[2] + b[3] * b[3]); }
                    if (TY == T_ZA || TY == T_ZB) { a = pg8::silu4(a); b = pg8::silu4(b); }
                    if (TY == T_G) { a = pg8::sigm4(a); b = pg8::sigm4(b); }
                    if (TY == T_Q || TY == T_K) {
                        f32x4 ra, rb;
                        ra[0] = a[0] * rc0[0] - a[1] * rc0[1]; ra[1] = a[1] * rc0[0] + a[0] * rc0[1];
                        ra[2] = a[2] * rc0[2] - a[3] * rc0[3]; ra[3] = a[3] * rc0[2] + a[2] * rc0[3];
                        rb[0] = b[0] * rc1[0] - b[1] * rc1[1]; rb[1] = b[1] * rc1[0] + b[0] * rc1[1];
                        rb[2] = b[2] * rc1[2] - b[3] * rc1[3]; rb[3] = b[3] * rc1[2] + b[2] * rc1[3];
                        a = ra; b = rb;
                        if (TY == T_Q) { a = a * QSCALE; b = b * QSCALE; }
                    }
                    if (TY == T_K) { if (win) { float* o = wk + wbase + (bj * 2 + (wc >> 1)) * HD + i0;
                        *(f32x4*)o = (f32x4){a[0], a[2], b[0], b[2]}; *(f32x4*)(o + 32) = (f32x4){a[1], a[3], b[1], b[3]}; } }
                    if (TY == T_VA) { if (win) { float* o = wk + wbase + (bj * 2 + (wc >> 1)) * HD + (cl & 63); *(f32x4*)o = a; *(f32x4*)(o + 4) = b; } }
                    const u32x4 w = pg8::pack8(a, b);
                    if (TY == T_G) *(u32x4*)(G + (size_t)row * GW + (col - Z1W)) = w;
                    else *(u32x4*)(Z1 + (size_t)row * Z1W + col) = w;
                }
                if (TY == T_V) {
                    ss += __shfl_xor(ss, 16); ss += __shfl_xor(ss, 32); sq += __shfl_xor(sq, 16); sq += __shfl_xor(sq, 32);
                    if (fq == 0) *(f32x2*)(stats + ((size_t)row * 16 + (u.pn - 4) * 4 + wc) * 2) = (f32x2){ss, sq};
                }
            }
    }
    __device__ __forceinline__ void operator()(f32x4 (&acc)[2][2][4][2], const Unit& u, int wr, int wc, int fr, int fq) const {
        asm volatile("" : "+v"(fr), "+v"(fq));
        const int pn = u.pn;
        if (pn < 4) tile<T_U>(acc, u, wr, wc, fr, fq);
        else if (pn < 8) tile<T_V>(acc, u, wr, wc, fr, fq);
        else if (pn < 12) tile<T_ZA>(acc, u, wr, wc, fr, fq);
        else if (pn < 16) tile<T_Q>(acc, u, wr, wc, fr, fq);
        else if (pn == 16) tile<T_K>(acc, u, wr, wc, fr, fq);
        else if (pn == 17) tile<T_VA>(acc, u, wr, wc, fr, fq);
        else if (pn < 22) tile<T_ZB>(acc, u, wr, wc, fr, fq);
        else tile<T_G>(acc, u, wr, wc, fr, fq);
    }
};
__device__ __forceinline__ void unpack8(u32x4 w, f32x4& a, f32x4& b) {
    a = (f32x4){pg8::bf_lo(w.x), pg8::bf_hi(w.x), pg8::bf_lo(w.y), pg8::bf_hi(w.y)}; b = (f32x4){pg8::bf_lo(w.z), pg8::bf_hi(w.z), pg8::bf_lo(w.w), pg8::bf_hi(w.w)};
}
__device__ __forceinline__ void store16_sc1(void* p, u32x4 v) { asm volatile("global_store_dwordx4 %0, %1, off sc1" :: "v"(p), "v"(v) : "memory"); }
struct EpiMerge {
    const bf16_t* G; bf16_t* MG; unsigned* mgcnt;
    __device__ __forceinline__ void operator()(f32x4 (&acc)[2][2][4][2], const Unit& u, int wr, int wc, int fr, int fq) const {
        asm volatile("" : "+v"(fr), "+v"(fq));
        const int cl = wc * 32 + 8 * fq; const int row0 = u.pm * 256 + wr * 64 + fr;
        const bf16_t* gp = G + (size_t)row0 * GW + u.pn * 256 + cl;
        if (u.kh == 0) {
#pragma unroll
            for (int ai = 0; ai < 2; ++ai)
#pragma unroll
                for (int m = 0; m < 4; ++m)
#pragma unroll
                    for (int bj = 0; bj < 2; ++bj) {
                        const bf16_t* p = gp + (size_t)(ai * 128 + m * 16) * GW + bj * 128;
                        f32x4 sb0, sb1, sa0, sa1; unpack8(*(const u32x4*)(p + DM), sb0, sb1); unpack8(*(const u32x4*)p, sa0, sa1);
#pragma unroll
                        for (int j = 0; j < 4; ++j) { acc[ai][bj][m][0][j] *= sa0[j] * __builtin_amdgcn_rcpf(sb0[j]); acc[ai][bj][m][1][j] *= sa1[j] * __builtin_amdgcn_rcpf(sb1[j]); }
                    }
        } else {
            u32x4 sbw[2][4][2];
#pragma unroll
            for (int ai = 0; ai < 2; ++ai)
#pragma unroll
                for (int m = 0; m < 4; ++m)
#pragma unroll
                    for (int bj = 0; bj < 2; ++bj) sbw[ai][m][bj] = *(const u32x4*)(gp + (size_t)(ai * 128 + m * 16) * GW + bj * 128 + DM);
            asm volatile("" ::: "memory");
            bf16_t* op = MG + (size_t)row0 * DM + u.pn * 256 + cl;
#pragma unroll
            for (int ai = 0; ai < 2; ++ai)
#pragma unroll
                for (int m = 0; m < 4; ++m)
#pragma unroll
                    for (int bj = 0; bj < 2; ++bj) { f32x4 sb0, sb1; unpack8(sbw[ai][m][bj], sb0, sb1);
                        *(u32x4*)(op + (size_t)(ai * 128 + m * 16) * DM + bj * 128) = pg8::pack8(acc[ai][bj][m][0] * sb0, acc[ai][bj][m][1] * sb1); }
            asm volatile("s_waitcnt vmcnt(0)" ::: "memory"); __builtin_amdgcn_s_barrier(); asm volatile("" ::: "memory");
            if (wr == 0 && wc == 0) { __builtin_amdgcn_fence(__ATOMIC_RELEASE, "agent"); asm volatile("s_waitcnt vmcnt(0)" ::: "memory");
                if (fr == 0 && fq == 0) (void)__hip_atomic_fetch_add(mgcnt + 64 * u.pm, 1u, __ATOMIC_RELAXED, __HIP_MEMORY_SCOPE_AGENT); }
        }
    }
};
struct EpiOutNorm {
    const float* xp; const float* xs; const float* g_post; float* Y; float* rowss; unsigned* cnt;
    template <int B> __device__ __forceinline__ void ldx(f32x4 (&xb)[2][2], const float* Xl) const {
#pragma unroll
        for (int bj = 0; bj < 2; ++bj) { const float* p = Xl + (size_t)((B >> 2) * 128 + (B & 3) * 16) * DM + bj * 128; xb[bj][0] = *(const f32x4*)p; xb[bj][1] = *(const f32x4*)(p + 4); }
    }
    template <int B> __device__ __forceinline__ void stx(const f32x4 (&xb)[2][2], f32x4 (&acc)[2][2][4][2], float* Yl, const float (&rstd)[8], const f32x4 (&gv)[2][2]) const {
#pragma unroll
        for (int bj = 0; bj < 2; ++bj) { constexpr int ai = B >> 2, m = B & 3; float* o = Yl + (size_t)(ai * 128 + m * 16) * DM + bj * 128; const float r = rstd[B];
            *(f32x4*)o = xb[bj][0] + acc[ai][bj][m][0] * r * gv[bj][0]; *(f32x4*)(o + 4) = xb[bj][1] + acc[ai][bj][m][1] * r * gv[bj][1]; }
    }
    __device__ __forceinline__ void operator()(f32x4 (&acc)[2][2][4][2], const Unit& u, int wr, int wc, int fr, int fq) const {
        asm volatile("" : "+v"(fr), "+v"(fq));
        const int cl = wc * 32 + 8 * fq; const int rbase = u.pm * 256 + wr * 64 + fr;
        const float* X = (u.pm < MP / 256) ? xp + (size_t)u.pm * 256 * DM : xs + (size_t)(u.pm - MP / 256) * 256 * DM;
        const float* Xl = X + (size_t)(wr * 64 + fr) * DM + u.pn * 256 + cl; float* Yl = Y + (size_t)rbase * DM + u.pn * 256 + cl;
        f32x4 xb0[2][2], xb1[2][2], xb2[2][2];
        ldx<0>(xb0, Xl);
        f32x4 gv[2][2];
#pragma unroll
        for (int bj = 0; bj < 2; ++bj) { gv[bj][0] = *(const f32x4*)(g_post + u.pn * 256 + bj * 128 + cl); gv[bj][1] = *(const f32x4*)(g_post + u.pn * 256 + bj * 128 + cl + 4); }
#pragma unroll
        for (int ai = 0; ai < 2; ++ai)
#pragma unroll
            for (int m = 0; m < 4; ++m) {
                float sq = 0.f;
#pragma unroll
                for (int bj = 0; bj < 2; ++bj) { const f32x4 a = acc[ai][bj][m][0], b = acc[ai][bj][m][1];
                    sq += (a[0] * a[0] + a[1] * a[1]) + (a[2] * a[2] + a[3] * a[3]) + (b[0] * b[0] + b[1] * b[1]) + (b[2] * b[2] + b[3] * b[3]); }
                sq += __shfl_xor(sq, 16); sq += __shfl_xor(sq, 32);
                if (fq == 0) (void)__hip_atomic_fetch_add(rowss + rbase + ai * 128 + m * 16, sq, __ATOMIC_RELAXED, __HIP_MEMORY_SCOPE_AGENT);
            }
        asm volatile("s_waitcnt vmcnt(0)" ::: "memory");
        unsigned* cw = cnt + 64 * u.pm;
        if (fr == 0 && fq == 0) (void)__hip_atomic_fetch_add(cw, 1u, __ATOMIC_RELAXED, __HIP_MEMORY_SCOPE_AGENT);
        { unsigned spins = 0;
          while ((unsigned)__builtin_amdgcn_readfirstlane(__hip_atomic_load(cw, __ATOMIC_RELAXED, __HIP_MEMORY_SCOPE_AGENT)) < 64u) { __builtin_amdgcn_s_sleep(1); if (++spins > (1u << 17)) break; } }
        __builtin_amdgcn_fence(__ATOMIC_ACQUIRE, "agent");
        float rstd[8];
#pragma unroll
        for (int i = 0; i < 8; ++i) rstd[i] = __hip_atomic_load(rowss + rbase + (i >> 2) * 128 + (i & 3) * 16, __ATOMIC_RELAXED, __HIP_MEMORY_SCOPE_AGENT);
#pragma unroll
        for (int i = 0; i < 8; ++i) rstd[i] = __builtin_amdgcn_rsqf(rstd[i] * (1.0f / DM) + EPS);
#define FENCE_ asm volatile("" ::: "memory")
        ldx<1>(xb1, Xl); ldx<2>(xb2, Xl); FENCE_; stx<0>(xb0, acc, Yl, rstd, gv); FENCE_;
        ldx<3>(xb0, Xl); FENCE_; stx<1>(xb1, acc, Yl, rstd, gv); FENCE_;
        ldx<4>(xb1, Xl); FENCE_; stx<2>(xb2, acc, Yl, rstd, gv); FENCE_;
        ldx<5>(xb2, Xl); FENCE_; stx<3>(xb0, acc, Yl, rstd, gv); FENCE_;
        ldx<6>(xb0, Xl); FENCE_; stx<4>(xb1, acc, Yl, rstd, gv); FENCE_;
        ldx<7>(xb1, Xl); FENCE_; stx<5>(xb2, acc, Yl, rstd, gv); FENCE_;
        stx<6>(xb0, acc, Yl, rstd, gv); stx<7>(xb1, acc, Yl, rstd, gv);
#undef FENCE_
    }
};

struct MOOrder {
    int c; const bf16_t *AB, *WpT, *MG, *WoutT; const unsigned* mgcnt;
    __device__ bool next(int i, Unit& u) const {
        const int j = c >> 3; u.pn = c & 7;
        const int n3 = ((j & 3) == 0 && j < 16) ? 3 : 2, n4 = ((j & 3) == 1 && j < 16) ? 3 : 2;
        if (i < 2 * n3) { const int t = i >> 1; u.kh = i & 1; u.ty = 0; u.pm = (t < 2) ? j + 32 * t : 64 + (j >> 2); return true; }
        const int k = i - 2 * n3; if (k >= n4) return false;
        u.kh = 0; u.ty = 1; u.pm = (k < 2) ? j + 32 * k : 64 + (j >> 2); return true;
    }
    __device__ __forceinline__ void operands(const Unit& u, const char*& A, const char*& B, int& nt) const {
        if (u.ty == 0) { A = (const char*)(AB + u.kh * AW) + (size_t)u.pm * pg8::TSTEP; B = (const char*)(WpT + u.kh * AW) + (size_t)u.pn * pg8::TSTEP; nt = AW / 64; }
        else { A = (const char*)MG + (size_t)u.pm * pg8::TSTEP; B = (const char*)WoutT + (size_t)u.pn * pg8::TSTEP; nt = DM / 64; }
    }
    __device__ __forceinline__ void a_ready(const Unit& u) const {
        if (u.ty != 1) return;
        if (threadIdx.x < 64) {
            unsigned spins = 0;
            while ((unsigned)__builtin_amdgcn_readfirstlane(__hip_atomic_load(mgcnt + 64 * u.pm, __ATOMIC_RELAXED, __HIP_MEMORY_SCOPE_AGENT)) < 8u) { __builtin_amdgcn_s_sleep(2); if (++spins > (1u << 17)) break; }
            __builtin_amdgcn_fence(__ATOMIC_ACQUIRE, "agent");
            asm volatile("s_waitcnt vmcnt(0)" ::: "memory");
        }
        asm volatile("" ::: "memory"); __builtin_amdgcn_s_barrier(); asm volatile("" ::: "memory");
    }
    __device__ __forceinline__ void done(const Unit&) const {}
};
struct EpiMO {
    static constexpr bool PERM = true, AFTER_DRAIN = false;
    static __device__ __forceinline__ bool zero_after(const Unit& u) { return u.ty == 1 || u.kh == 1; }
    EpiMerge em; EpiOutNorm eo;
    __device__ __forceinline__ void operator()(f32x4 (&acc)[2][2][4][2], const Unit& u, int wr, int wc, int fr, int fq) const {
        if (u.ty == 0) em(acc, u, wr, wc, fr, fq); else eo(acc, u, wr, wc, fr, fq);
    }
};
#define XB_TMO      128
#define XB_XCNT(j)  (256  + 64 * (j))
#define XB_XSUB(j)  (1280 + 64 * (j))
#define XB_XGEN(j)  (2304 + 64 * (j))
#define XB_TOP      3328
#define XB_TOPGEN   3392
#define XCD_BAR_WORDS 3456
#define XB_SPIN_CAP (1u << 18)

__device__ __forceinline__ unsigned xb_ld(unsigned* p)              { return __hip_atomic_load(p, __ATOMIC_RELAXED, __HIP_MEMORY_SCOPE_AGENT); }
__device__ __forceinline__ unsigned xb_add(unsigned* p, unsigned v) { return __hip_atomic_fetch_add(p, v, __ATOMIC_RELAXED, __HIP_MEMORY_SCOPE_AGENT); }
__device__ __forceinline__ unsigned xb_xcc_id() { return (unsigned)__builtin_amdgcn_s_getreg((3 << 11) | 20) & 0xFu; }
#define XB_SPIN(cond, bar) do { unsigned _sp = 0; while (cond) { __builtin_amdgcn_s_sleep(1); \
    if ((++_sp & 255u) == 0u) { if (xb_ld(&(bar)[XB_TMO])) break; if (_sp > XB_SPIN_CAP) { atomicAdd(&(bar)[XB_TMO], 1u); break; } } } } while (0)

struct XcdBarrier {
    unsigned* bar; unsigned x;
    volatile LAS unsigned* st;
};

__device__ __forceinline__ XcdBarrier xcd_barrier_post(unsigned* bar, volatile LAS unsigned* st) {
    XcdBarrier b; b.bar = bar; b.x = xb_xcc_id(); b.st = st;
    if (threadIdx.x == 0) (void)xb_add(&bar[XB_XCNT(b.x)], 1u);
    return b;
}
__device__ __forceinline__ void xcd_barrier_complete(unsigned* bar, unsigned x, unsigned& nloc, unsigned& nx) {
    const unsigned G = gridDim.x * gridDim.y * gridDim.z;
    unsigned sum, cnt, mine, sp = 0u;
    for (;;) {
        sum = 0u; cnt = 0u; mine = 0u;
#pragma unroll
        for (unsigned j = 0; j < 16; ++j) { const unsigned c = xb_ld(&bar[XB_XCNT(j)]); sum += c; cnt += (c > 0u) ? 1u : 0u; mine = (j == x) ? c : mine; }
        if (sum == G) break;
        __builtin_amdgcn_s_sleep(1);
        if ((++sp & 255u) == 0u) { if (xb_ld(&bar[XB_TMO])) break; if (sp > XB_SPIN_CAP) { atomicAdd(&bar[XB_TMO], 1u); break; } }
    }
    nloc = mine > 0u ? mine : 1u; nx = cnt > 0u ? cnt : 1u;
}

__device__ __forceinline__ void xcd_barrier(const XcdBarrier& b) {
    asm volatile("s_waitcnt vmcnt(0)" ::: "memory");
    __syncthreads();
    if (threadIdx.x == 0) {
        unsigned* bar = b.bar;
        __builtin_amdgcn_s_waitcnt(0);
        unsigned nloc = b.st[0], nx = b.st[1];
        if (nloc == 0u) { xcd_barrier_complete(bar, b.x, nloc, nx); b.st[0] = nloc; b.st[1] = nx; }
        const unsigned old = xb_add(&bar[XB_XSUB(b.x)], 1u);
        const unsigned gen = old / nloc;
        if (old + 1u == (gen + 1u) * nloc) {
            __builtin_amdgcn_fence(__ATOMIC_RELEASE, "agent");
            asm volatile("s_waitcnt vmcnt(0)" ::: "memory");
            const unsigned og = xb_add(&bar[XB_TOP], 1u);
            const unsigned tg = og / nx;
            if (og + 1u == (tg + 1u) * nx) xb_add(&bar[XB_TOPGEN], 1u);
            else XB_SPIN(xb_ld(&bar[XB_TOPGEN]) == tg, bar);
            __builtin_amdgcn_fence(__ATOMIC_ACQUIRE, "agent");
            xb_add(&bar[XB_XGEN(b.x)], 1u);
            asm volatile("s_waitcnt vmcnt(0)" ::: "memory");
        } else {
            XB_SPIN(xb_ld(&bar[XB_XGEN(b.x)]) == gen, bar);
            __builtin_amdgcn_fence(__ATOMIC_ACQUIRE, "agent");
            asm volatile("s_waitcnt vmcnt(0)" ::: "memory");
        }
    }
    __syncthreads();
}

__device__ __forceinline__ float wave_sum(float v) {
#pragma unroll
    for (int o = 1; o < 64; o <<= 1) v += __shfl_xor(v, o);
    return v;
}
__device__ __forceinline__ unsigned f2bf(float f) { unsigned u = __float_as_uint(f); return (u + 0x7fffu + ((u >> 16) & 1u)) >> 16; }
__device__ __forceinline__ unsigned pk2(float lo, float hi) { return pg8::cvt_pk_bf16(lo, hi); }
#define LDS_WAIT() asm volatile("s_waitcnt lgkmcnt(0)" ::: "memory")

struct Ptrs {
    const float *xp, *xs, *ck, *cv, *g_pre, *w_in, *ln_g, *ln_b, *w_sp, *b_sp, *sinks, *w_pa, *w_pb, *w_out, *g_post;
    float* out; unsigned char* ws;
};
static __device__ const double kInvFreq[32] = {1.0, 0.7498942093324559, 0.5623413251903491, 0.4216965034285822, 0.31622776601683794, 0.23713737056616552, 0.1778279410038923, 0.1333521432163324, 0.1, 0.07498942093324558, 0.05623413251903491, 0.042169650342858224, 0.03162277660168379, 0.023713737056616554, 0.01778279410038923, 0.01333521432163324, 0.01, 0.007498942093324558, 0.005623413251903491, 0.004216965034285823, 0.0031622776601683794, 0.0023713737056616554, 0.0017782794100389228, 0.001333521432163324, 0.001, 0.0007498942093324559, 0.0005623413251903491, 0.00042169650342858224, 0.00031622776601683794, 0.00023713737056616554, 0.00017782794100389227, 0.0001333521432163324};

template <bool QKPERM>
__device__ __forceinline__ void p0_transpose_item(const float* W, int N, bf16_t* WT, int ldt, int koff, LAS float* scr, int item, int lane) {
    const int nblk = N / 32, kb = item / nblk, nb = item % nblk, k0 = 64 * kb, n0 = 32 * nb;
#pragma unroll 8
    for (int i = 0; i < 32; ++i) { const int kk = 2 * i + (lane >> 5); scr[kk * 33 + (lane & 31)] = W[(size_t)(k0 + kk) * N + n0 + (lane & 31)]; }
    LDS_WAIT(); asm volatile("" ::: "memory");
    const int c = lane & 7;
#pragma unroll
    for (int j = 0; j < 4; ++j) { const int n = (lane >> 3) + 8 * j; const LAS float* s = scr + (8 * c) * 33 + n;
        u32x4 o; o.x = pk2(s[0 * 33], s[1 * 33]); o.y = pk2(s[2 * 33], s[3 * 33]); o.z = pk2(s[4 * 33], s[5 * 33]); o.w = pk2(s[6 * 33], s[7 * 33]);
        int nn = n0 + n;
        if (QKPERM) { if (nn >= C_Q && nn < C_VA) { const int d = nn & 63; nn = (nn & ~63) + 2 * (d & 31) + (d >> 5); } }
        *(u32x4*)(WT + (size_t)nn * ldt + koff + k0 + 8 * c) = o; }
    LDS_WAIT(); asm volatile("" ::: "memory");
}
__device__ __forceinline__ void p0_prologue(const Ptrs& P, LAS unsigned char* lds, int vcu, int G, int wave, int lane, int tid) {
    LAS float* scr = (LAS float*)(lds + wave * 16384);
    const int gw = vcu * NWAVES + wave, NGW = G * NWAVES;
    bf16_t* WinT = (bf16_t*)(P.ws + WS_WIN); bf16_t* WpT = (bf16_t*)(P.ws + WS_WP); bf16_t* WoutT = (bf16_t*)(P.ws + WS_WOUT);
    constexpr int I_IN = (DM / 64) * (INC / 32), I_PA = (AW / 64) * (DM / 32), I_PB = (BW / 64) * (DM / 32), I_OUT = (DM / 64) * (DM / 32);
    constexpr int NITEMS = I_IN + I_PA + I_PB + I_OUT;
    for (int it = gw; it < NITEMS; it += NGW) {
        int r = it;
        if (r < I_IN) { p0_transpose_item<true>(P.w_in, INC, WinT, DM, 0, scr, r, lane); continue; } r -= I_IN;
        if (r < I_PA) { p0_transpose_item<false>(P.w_pa, DM, WpT, 2048, 0, scr, r, lane); continue; } r -= I_PA;
        if (r < I_PB) { p0_transpose_item<false>(P.w_pb, DM, WpT, 2048, 1024, scr, r, lane); continue; } r -= I_PB;
        p0_transpose_item<false>(P.w_out, DM, WoutT, DM, 0, scr, r, lane);
    }
    bf16_t* H = (bf16_t*)(P.ws + WS_H);
    for (int m = gw; m < M; m += NGW) {
        const float* xrow = m < MP ? P.xp + (size_t)m * DM : P.xs + (size_t)(m - MP) * DM;
        const f32x4* xr = (const f32x4*)xrow + lane; f32x4 v[8]; float s = 0.f;
#pragma unroll
        for (int j = 0; j < 8; ++j) { v[j] = xr[64 * j]; s += (v[j][0] * v[j][0] + v[j][1] * v[j][1]) + (v[j][2] * v[j][2] + v[j][3] * v[j][3]); }
        const float rstd = 1.0f / sqrtf(wave_sum(s) * (1.0f / DM) + EPS);
        u32x2* o = (u32x2*)(H + (size_t)m * DM) + lane;
#pragma unroll
        for (int j = 0; j < 8; ++j) { const f32x4 g = ((const f32x4*)P.g_pre)[lane + 64 * j]; const f32x4 y = v[j] * rstd * g; u32x2 w; w.x = pk2(y[0], y[1]); w.y = pk2(y[2], y[3]); o[64 * j] = w; }
    }
    float* rope = (float*)(P.ws + WS_ROPE);
    const int gt = vcu * NTHR + tid, NGT = G * NTHR;
    for (int e = gt; e < NTPOS * 32; e += NGT) {
        const int tp = e >> 5, i = e & 31; const int pos = tp < SEQ ? tp : PAST + (tp - SEQ);
        const double a = (double)pos * kInvFreq[i]; const double k = __builtin_rint(a * 0.15915494309189535); const float r = (float)(a - k * 6.283185307179586);
        *(f32x2*)(rope + (size_t)e * 2) = (f32x2){__cosf(r), __sinf(r)};
    }
    { unsigned* z = (unsigned*)(P.ws + WS_SSQ); for (int e = gt; e < M + 2 * 68 * 64; e += NGT) z[e] = 0u; }
    constexpr int NV = DB * (WIN - DS) * (KVW / 4);
    for (int e = gt; e < 2 * NV; e += NGT) {
        const int which = e >= NV; const int r = which ? e - NV : e; const int db = r / ((WIN - DS) * (KVW / 4)), q = r % ((WIN - DS) * (KVW / 4));
        const f32x4* src = (const f32x4*)(which ? P.cv : P.ck) + (size_t)db * WIN * (KVW / 4) + DS * (KVW / 4) + q;
        f32x4* dst = (f32x4*)(P.out + (which ? O_VWS : O_KWS)) + (size_t)db * WIN * (KVW / 4) + q;
        *dst = *src;
    }
}

constexpr int KS_STRIDE = 72, VT_STRIDE = 264;
constexpr int A_STRIDE = 136;
template <int NKT, int MODE>
__device__ __forceinline__ void attn_qtile(const bf16_t* qp, LAS const unsigned char* Ks, LAS const unsigned char* VTs, int lane, int qt, bool first, float sink2,
                                           bf16_t* op, const bf16_t* zp) {
    const int n = lane & 15, quad = lane >> 4;
    const bf16x8 qf0 = *(const bf16x8*)(qp + quad * 8), qf1 = *(const bf16x8*)(qp + 32 + quad * 8);
    f32x4 s[NKT];
    const int qi = (MODE == 0) ? qt * 16 + n : (n & 7);
#pragma unroll
    for (int kt = 0; kt < NKT; ++kt) {
        bool need;
        if (MODE == 0) need = (kt < 8) ? (!first && kt >= qt) : (kt - 8 <= qt); else need = kt < 9;
        s[kt] = (f32x4){-1e30f, -1e30f, -1e30f, -1e30f};
        if (need) {
            const LAS unsigned char* kp = Ks + (kt * 16 + n) * (KS_STRIDE * 2) + quad * 16;
            const bf16x8 k0 = *(const LAS bf16x8*)kp, k1 = *(const LAS bf16x8*)(kp + 64);
            f32x4 c = {0.f, 0.f, 0.f, 0.f};
            c = __builtin_amdgcn_mfma_f32_16x16x32_bf16(k0, qf0, c, 0, 0, 0);
            c = __builtin_amdgcn_mfma_f32_16x16x32_bf16(k1, qf1, c, 0, 0, 0);
#pragma unroll
            for (int j = 0; j < 4; ++j) { const int kk = kt * 16 + quad * 4 + j; bool vis;
                if (MODE == 0) vis = (kk < 128) ? (kk > qi) : (kk - 128 <= qi); else vis = (kk < 128) ? (kk > qi) : (kk - 128 <= qi);
                s[kt][j] = vis ? c[j] : -1e30f; }
        }
    }
    float mx = -1e30f;
#pragma unroll
    for (int kt = 0; kt < NKT; ++kt) mx = fmaxf(mx, fmaxf(fmaxf(s[kt][0], s[kt][1]), fmaxf(s[kt][2], s[kt][3])));
    mx = fmaxf(mx, __shfl_xor(mx, 16)); mx = fmaxf(mx, __shfl_xor(mx, 32)); mx = fmaxf(mx, sink2);
    float sum = 0.f;
#pragma unroll
    for (int kt = 0; kt < NKT; ++kt) {
#pragma unroll
        for (int j = 0; j < 4; ++j) { const float p = __builtin_amdgcn_exp2f(s[kt][j] - mx); s[kt][j] = p; sum += p; } }
    sum += __shfl_xor(sum, 16); sum += __shfl_xor(sum, 32); sum += __builtin_amdgcn_exp2f(sink2 - mx);
    const float inv = 1.0f / sum;
    f32x4 o[4];
#pragma unroll
    for (int dt = 0; dt < 4; ++dt) o[dt] = (f32x4){0.f, 0.f, 0.f, 0.f};
#pragma unroll
    for (int pp = 0; pp < NKT / 2; ++pp) {
        bool need;
        if (MODE == 0) need = (pp < 4) ? (!first && 2 * pp + 1 >= qt) : (2 * pp - 8 <= qt); else need = pp < 5;
        if (need) {
            u32x4 pw; pw.x = pk2(s[2 * pp][0], s[2 * pp][1]); pw.y = pk2(s[2 * pp][2], s[2 * pp][3]); pw.z = pk2(s[2 * pp + 1][0], s[2 * pp + 1][1]); pw.w = pk2(s[2 * pp + 1][2], s[2 * pp + 1][3]);
            const bf16x8 pf = __builtin_bit_cast(bf16x8, pw);
#pragma unroll
            for (int dt = 0; dt < 4; ++dt) {
                const LAS unsigned char* vp = VTs + (dt * 16 + n) * (VT_STRIDE * 2) + (pp * 32 + quad * 4) * 2;
                const u32x2 v0 = *(const LAS u32x2*)vp, v1 = *(const LAS u32x2*)(vp + 32);
                const u32x4 vw = {v0.x, v0.y, v1.x, v1.y};
                o[dt] = __builtin_amdgcn_mfma_f32_16x16x32_bf16(__builtin_bit_cast(bf16x8, vw), pf, o[dt], 0, 0, 0);
            }
        }
    }
#pragma unroll
    for (int dt = 0; dt < 4; ++dt) {
        const u32x2 zw = *(const u32x2*)(zp + dt * 16 + quad * 4);
        const f32x4 z = {pg8::bf_lo(zw.x), pg8::bf_hi(zw.x), pg8::bf_lo(zw.y), pg8::bf_hi(zw.y)};
        const f32x4 r = o[dt] * inv * z; u32x2 w; w.x = pk2(r[0], r[1]); w.y = pk2(r[2], r[3]);
        *(u32x2*)(op + dt * 16 + quad * 4) = w;
    }
}
__device__ __forceinline__ void p2_mixers(const Ptrs& P, LAS unsigned char* lds, int vcu, int G, int wave, int lane, int tid) {
    bf16_t* Z1 = (bf16_t*)(P.ws + WS_Z1); bf16_t* AB = (bf16_t*)(P.ws + WS_H); const float* stats = (const float*)(P.ws + WS_STATS);
    {
        LAS unsigned char* vnT = lds; LAS unsigned char* Wl = lds + 128 * A_STRIDE * 2; LAS float* mr = (LAS float*)(lds + 2 * 128 * A_STRIDE * 2);
        for (int un = vcu; un < (MP / CH) * NG; un += G) {
            const int ci = un >> 3, g = un & 7, row0 = ci * CH;
            if (tid < CH) {
                const f32x4* sp = (const f32x4*)(stats + (size_t)(row0 + tid) * 32); float s = 0.f, q = 0.f;
#pragma unroll
                for (int j = 0; j < 8; ++j) { const f32x4 v = sp[j]; s += v[0] + v[2]; q += v[1] + v[3]; }
                const float mean = s * (1.0f / AW), var = q * (1.0f / AW) - mean * mean;
                mr[tid * 2] = mean; mr[tid * 2 + 1] = 1.0f / sqrtf(fmaxf(var, 0.f) + EPS);
            }
#pragma unroll
            for (int i = 0; i < 8; ++i) { const int e = tid + i * NTHR, t = e >> 5, s0 = (e & 31) * 4;
                const f32x4 w = *(const f32x4*)(P.w_sp + ((size_t)g * CH + t) * CH + s0);
                u32x2 o; o.x = pk2(s0 <= t ? w[0] : 0.f, s0 + 1 <= t ? w[1] : 0.f); o.y = pk2(s0 + 2 <= t ? w[2] : 0.f, s0 + 3 <= t ? w[3] : 0.f);
                *(LAS u32x2*)(Wl + t * (A_STRIDE * 2) + s0 * 2) = o; }
            __syncthreads();
#pragma unroll
            for (int i = 0; i < 4; ++i) { const int e = tid + i * NTHR, s = e >> 4, c0 = (e & 15) * 8;
                f32x4 a, b; unpack8(*(const u32x4*)(Z1 + (size_t)(row0 + s) * Z1W + C_V + g * CH + c0), a, b);
                const float mean = mr[s * 2], rstd = mr[s * 2 + 1];
                const f32x4 g0 = *(const f32x4*)(P.ln_g + g * CH + c0), g1 = *(const f32x4*)(P.ln_g + g * CH + c0 + 4), b0 = *(const f32x4*)(P.ln_b + g * CH + c0), b1 = *(const f32x4*)(P.ln_b + g * CH + c0 + 4);
                a = (a - mean) * rstd * g0 + b0; b = (b - mean) * rstd * g1 + b1;
#pragma unroll
                for (int j = 0; j < 4; ++j) { *(LAS bf16_t*)(vnT + (c0 + j) * (A_STRIDE * 2) + s * 2) = (bf16_t)f2bf(a[j]); *(LAS bf16_t*)(vnT + (c0 + 4 + j) * (A_STRIDE * 2) + s * 2) = (bf16_t)f2bf(b[j]); } }
            __syncthreads();
            {
                const int n = lane & 15, quad = lane >> 4, t = wave * 16 + n; const int nks = (wave >> 1) + 1;
                f32x4 acc[8];
#pragma unroll
                for (int ct = 0; ct < 8; ++ct) acc[ct] = (f32x4){0.f, 0.f, 0.f, 0.f};
                for (int ks = 0; ks < nks; ++ks) {
                    const bf16x8 wf = *(const LAS bf16x8*)(Wl + t * (A_STRIDE * 2) + (ks * 32 + quad * 8) * 2);
#pragma unroll
                    for (int ct = 0; ct < 8; ++ct) { const bf16x8 vf = *(const LAS bf16x8*)(vnT + (ct * 16 + n) * (A_STRIDE * 2) + (ks * 32 + quad * 8) * 2);
                        acc[ct] = __builtin_amdgcn_mfma_f32_16x16x32_bf16(vf, wf, acc[ct], 0, 0, 0); }
                }
                const int row = row0 + t; const float bs = P.b_sp[g * CH + t];
#pragma unroll
                for (int ct = 0; ct < 8; ++ct) { const int col = g * CH + ct * 16 + quad * 4;
                    const u32x2 uw = *(const u32x2*)(Z1 + (size_t)row * Z1W + C_U + col), zw = *(const u32x2*)(Z1 + (size_t)row * Z1W + C_ZA + col);
                    const f32x4 uu = {pg8::bf_lo(uw.x), pg8::bf_hi(uw.x), pg8::bf_lo(uw.y), pg8::bf_hi(uw.y)}, zz = {pg8::bf_lo(zw.x), pg8::bf_hi(zw.x), pg8::bf_lo(zw.y), pg8::bf_hi(zw.y)};
                    const f32x4 r = uu * (acc[ct] + bs) * zz; u32x2 w; w.x = pk2(r[0], r[1]); w.y = pk2(r[2], r[3]);
                    *(u32x2*)(AB + (size_t)row * 2048 + col) = w; }
            }
            __syncthreads();
        }
    }
    {
        LAS float* mr = (LAS float*)lds;
        for (int db = vcu; db < DB; db += G) {
            const int row0 = MP + db * DS;
            if (tid < DS) {
                const f32x4* sp = (const f32x4*)(stats + (size_t)(row0 + tid) * 32); float s = 0.f, q = 0.f;
#pragma unroll
                for (int j = 0; j < 8; ++j) { const f32x4 v = sp[j]; s += v[0] + v[2]; q += v[1] + v[3]; }
                const float mean = s * (1.0f / AW), var = q * (1.0f / AW) - mean * mean;
                mr[tid * 2] = mean; mr[tid * 2 + 1] = 1.0f / sqrtf(fmaxf(var, 0.f) + EPS);
            }
            __syncthreads();
            const int c = tid * 2, g = c >> 7;
            const f32x2 lg = *(const f32x2*)(P.ln_g + c), lb = *(const f32x2*)(P.ln_b + c);
            f32x2 vn[DS];
#pragma unroll
            for (int s = 0; s < DS; ++s) { const unsigned w = *(const unsigned*)(Z1 + (size_t)(row0 + s) * Z1W + C_V + c);
                const float mean = mr[s * 2], rstd = mr[s * 2 + 1];
                vn[s] = (f32x2){(pg8::bf_lo(w) - mean) * rstd * lg.x + lb.x, (pg8::bf_hi(w) - mean) * rstd * lg.y + lb.y};
                *(f32x2*)(P.out + O_CV + (size_t)(db * DS + s) * AW + c) = vn[s]; }
#pragma unroll
            for (int t = 0; t < DS; ++t) {
                const float bs = P.b_sp[g * CH + t]; f32x2 acc = {bs, bs};
#pragma unroll
                for (int s = 0; s <= t; ++s) { const float w = P.w_sp[((size_t)g * CH + t) * CH + s]; acc += vn[s] * w; }
                const unsigned uw = *(const unsigned*)(Z1 + (size_t)(row0 + t) * Z1W + C_U + c), zw = *(const unsigned*)(Z1 + (size_t)(row0 + t) * Z1W + C_ZA + c);
                *(unsigned*)(AB + (size_t)(row0 + t) * 2048 + c) = pk2(pg8::bf_lo(uw) * acc.x * pg8::bf_lo(zw), pg8::bf_hi(uw) * acc.y * pg8::bf_hi(zw));
            }
            __syncthreads();
        }
    }
    LAS unsigned char* Ks = lds; LAS unsigned char* VTs = lds + 256 * KS_STRIDE * 2;
    for (int un = vcu; un < NB * NKV * (SEQ / WIN); un += G) {
        const int blk = un & 15, kvh = (un >> 4) & 3, b = un >> 6; const bool first = blk == 0;
        const int krow0 = b * SEQ + (blk - 1) * WIN;
#pragma unroll
        for (int i = 0; i < 4; ++i) { const int e = tid + i * NTHR, key = e >> 3, c8 = (e & 7) * 8;
            if (!(first && key < WIN)) {
                const size_t zr = (size_t)(krow0 + key) * Z1W;
                const u32x4 kw = *(const u32x4*)(Z1 + zr + C_K + kvh * HD + c8);
                *(LAS u32x4*)(Ks + key * (KS_STRIDE * 2) + c8 * 2) = kw;
                const u32x4 vw = *(const u32x4*)(Z1 + zr + C_VA + kvh * HD + c8);
                LAS unsigned char* vt = VTs + c8 * (VT_STRIDE * 2) + key * 2;
                *(LAS bf16_t*)(vt + 0 * VT_STRIDE * 2) = (bf16_t)(vw.x & 0xffff); *(LAS bf16_t*)(vt + 1 * VT_STRIDE * 2) = (bf16_t)(vw.x >> 16);
                *(LAS bf16_t*)(vt + 2 * VT_STRIDE * 2) = (bf16_t)(vw.y & 0xffff); *(LAS bf16_t*)(vt + 3 * VT_STRIDE * 2) = (bf16_t)(vw.y >> 16);
                *(LAS bf16_t*)(vt + 4 * VT_STRIDE * 2) = (bf16_t)(vw.z & 0xffff); *(LAS bf16_t*)(vt + 5 * VT_STRIDE * 2) = (bf16_t)(vw.z >> 16);
                *(LAS bf16_t*)(vt + 6 * VT_STRIDE * 2) = (bf16_t)(vw.w & 0xffff); *(LAS bf16_t*)(vt + 7 * VT_STRIDE * 2) = (bf16_t)(vw.w >> 16);
            } }
        __syncthreads();
        {
            const int head = kvh * 4 + (wave >> 1); const float sink2 = P.sinks[head] * LOG2E;
            for (int q4 = 0; q4 < 4; ++q4) {
                const int qt = (wave & 1) * 4 + q4; const int row = b * SEQ + blk * WIN + qt * 16 + (lane & 15);
                attn_qtile<16, 0>(Z1 + (size_t)row * Z1W + C_Q + head * HD, Ks, VTs, lane, qt, first, sink2, AB + (size_t)row * 2048 + AW + head * HD, Z1 + (size_t)row * Z1W + C_ZB + head * HD);
            }
        }
        __syncthreads();
    }
    for (int un = vcu; un < DB * NKV; un += G) {
        const int kvh = un & 3, db = un >> 2; const int row0 = MP + db * DS;
#pragma unroll
        for (int i = 0; i < 4; ++i) { const int e = tid + i * NTHR, key = e >> 4, d0 = (e & 15) * 4;
            const size_t src = ((size_t)(db * WIN + key) * NKV + kvh) * HD + d0;
            const f32x4 kv = *(const f32x4*)(P.ck + src); const f32x4 vv = *(const f32x4*)(P.cv + src);
            const int i0 = d0 & 31, eo = d0 >> 5;
#pragma unroll
            for (int j = 0; j < 4; ++j) { *(LAS bf16_t*)(Ks + key * (KS_STRIDE * 2) + (2 * (i0 + j) + eo) * 2) = (bf16_t)f2bf(kv[j]);
                                          *(LAS bf16_t*)(VTs + (d0 + j) * (VT_STRIDE * 2) + key * 2) = (bf16_t)f2bf(vv[j]); } }
        if (tid < 32 * 8) { const int key = 128 + (tid >> 3), c8 = (tid & 7) * 8; u32x4 kw = {0u, 0u, 0u, 0u}, vw = {0u, 0u, 0u, 0u};
            if (key < 128 + DS) { const size_t zr = (size_t)(row0 + key - 128) * Z1W; kw = *(const u32x4*)(Z1 + zr + C_K + kvh * HD + c8); vw = *(const u32x4*)(Z1 + zr + C_VA + kvh * HD + c8); }
            *(LAS u32x4*)(Ks + key * (KS_STRIDE * 2) + c8 * 2) = kw;
            LAS unsigned char* vt = VTs + c8 * (VT_STRIDE * 2) + key * 2;
            *(LAS bf16_t*)(vt + 0 * VT_STRIDE * 2) = (bf16_t)(vw.x & 0xffff); *(LAS bf16_t*)(vt + 1 * VT_STRIDE * 2) = (bf16_t)(vw.x >> 16);
            *(LAS bf16_t*)(vt + 2 * VT_STRIDE * 2) = (bf16_t)(vw.y & 0xffff); *(LAS bf16_t*)(vt + 3 * VT_STRIDE * 2) = (bf16_t)(vw.y >> 16);
            *(LAS bf16_t*)(vt + 4 * VT_STRIDE * 2) = (bf16_t)(vw.z & 0xffff); *(LAS bf16_t*)(vt + 5 * VT_STRIDE * 2) = (bf16_t)(vw.z >> 16);
            *(LAS bf16_t*)(vt + 6 * VT_STRIDE * 2) = (bf16_t)(vw.w & 0xffff); *(LAS bf16_t*)(vt + 7 * VT_STRIDE * 2) = (bf16_t)(vw.w >> 16);
        }
        __syncthreads();
        if (wave < 2) {
            const int n = lane & 15; const int head = kvh * 4 + wave * 2 + (n >> 3); const int row = row0 + (n & 7);
            attn_qtile<10, 1>(Z1 + (size_t)row * Z1W + C_Q + head * HD, Ks, VTs, lane, 0, false, P.sinks[head] * LOG2E, AB + (size_t)row * 2048 + AW + head * HD, Z1 + (size_t)row * Z1W + C_ZB + head * HD);
        }
        __syncthreads();
    }
}

struct Args { Ptrs p; int ph_lo, ph_hi; };
typedef const __attribute__((address_space(4))) Args* KArgPtr;
__device__ __forceinline__ Ptrs load_ptrs() {
    KArgPtr ap = (KArgPtr)__builtin_amdgcn_kernarg_segment_ptr(); asm volatile("" : "+s"(ap));
    Ptrs P; P.xp = ap->p.xp; P.xs = ap->p.xs; P.ck = ap->p.ck; P.cv = ap->p.cv; P.g_pre = ap->p.g_pre; P.w_in = ap->p.w_in; P.ln_g = ap->p.ln_g; P.ln_b = ap->p.ln_b;
    P.w_sp = ap->p.w_sp; P.b_sp = ap->p.b_sp; P.sinks = ap->p.sinks; P.w_pa = ap->p.w_pa; P.w_pb = ap->p.w_pb; P.w_out = ap->p.w_out; P.g_post = ap->p.g_post; P.out = ap->p.out; P.ws = ap->p.ws;
    return P;
}
__global__ void __launch_bounds__(NTHR, 2) fwd_kernel(Args args) {
    extern __shared__ __attribute__((aligned(16))) unsigned char lds_raw[];
    LAS unsigned char* lds = (LAS unsigned char*)lds_raw;
    const int tid = threadIdx.x, lane = tid & 63, wave = __builtin_amdgcn_readfirstlane(tid >> 6);
    const int G = gridDim.x, bx = blockIdx.x; const int vcu = (G % 8 == 0) ? (bx % 8) * (G / 8) + bx / 8 : bx;
    const int lo = args.ph_lo, hi = args.ph_hi;
#ifndef PH_MASK
#define PH_MASK 63
#endif
#define IN(k) (((PH_MASK >> (k)) & 1) && lo <= (k) && (k) < hi)
#ifndef DUP_MASK
#define DUP_MASK 0
#endif
#define REP(k) for (int rep_ = 0; rep_ < (((DUP_MASK >> (k)) & 1) ? 2 : 1); ++rep_)
#define SEAM(k) do { if (IN(k) && IN((k) + 1)) xcd_barrier(bar); } while (0)
    if (lo == -12345) cg::this_grid().sync();
    volatile LAS unsigned* st = (volatile LAS unsigned*)(lds + 131072 + 64);
    if (tid < 2) st[tid] = 0u;
    __syncthreads();
    XcdBarrier bar; bar.bar = nullptr; bar.x = 0; bar.st = nullptr;
    if (hi - lo > 1) { KArgPtr ap0 = (KArgPtr)__builtin_amdgcn_kernarg_segment_ptr(); bar = xcd_barrier_post((unsigned*)(ap0->p.ws + WS_CTL), st); }
    if (IN(0)) REP(0) { const Ptrs P = load_ptrs(); p0_prologue(P, lds, vcu, G, wave, lane, tid); __syncthreads(); }
    SEAM(0);
    if (IN(1)) REP(1) {
        const Ptrs P = load_ptrs();
        bf16_t* WinT = (bf16_t*)(P.ws + WS_WIN); bf16_t* H = (bf16_t*)(P.ws + WS_H);
        pg8::StaticOrder S; S.init(M, INC, G, bx, 1); S.A0 = H; S.A1 = H; S.Bt0 = WinT; S.Bt1 = WinT; S.ntile = DM / 64;
        EpiIn E{(bf16_t*)(P.ws + WS_Z1), (bf16_t*)(P.ws + WS_G), (float*)(P.ws + WS_STATS), (const float*)(P.ws + WS_ROPE), P.out};
        pg8::gemm_phase<EpiIn, pg8::StaticOrder, true, true>(lds, S, E);
    }
    SEAM(1);
    if (IN(2)) REP(2) { const Ptrs P = load_ptrs(); p2_mixers(P, lds, vcu, G, wave, lane, tid); }
    SEAM(2);
    if (IN(3)) {
        const Ptrs P = load_ptrs();
        unsigned* ctr = (unsigned*)(P.ws + WS_SSQ);
        MOOrder S; S.c = vcu; S.AB = (const bf16_t*)(P.ws + WS_H); S.WpT = (const bf16_t*)(P.ws + WS_WP); S.MG = (const bf16_t*)(P.ws + WS_Z1); S.WoutT = (const bf16_t*)(P.ws + WS_WOUT); S.mgcnt = ctr + M + 68 * 64;
        EpiMO E{EpiMerge{(const bf16_t*)(P.ws + WS_G), (bf16_t*)(P.ws + WS_Z1), ctr + M + 68 * 64}, EpiOutNorm{P.xp, P.xs, P.g_post, P.out + O_Y, (float*)ctr, ctr + M}};
        pg8::gemm_phase<EpiMO, MOOrder, true, true>(lds, S, E);
    }
#undef IN
#undef SEAM
}

extern "C" void kernel_launch(void* const* d_in, const int* in_sizes, int n_in, void* d_out, int out_size, void* d_ws, size_t ws_size, hipStream_t stream) {
    static int grid = 0;
    if (grid == 0) {
        if (n_in != 15 || in_sizes[0] != MP * DM || (size_t)out_size != O_END || ws_size < WS_END) {
            fprintf(stderr, "kernel_launch: unexpected shapes (n_in %d, in0 %d, out %d, ws %zu, need %zu)\n", n_in, n_in > 0 ? in_sizes[0] : -1, out_size, ws_size, (size_t)WS_END); grid = -1; return; }
        if (hipFuncSetAttribute((const void*)fwd_kernel, hipFuncAttributeMaxDynamicSharedMemorySize, LDS_BYTES) != hipSuccess) { fprintf(stderr, "kernel_launch: hipFuncSetAttribute failed\n"); grid = -1; return; }
        int dev = 0, cus = 0, per_cu = 0;
        hipGetDevice(&dev); hipDeviceGetAttribute(&cus, hipDeviceAttributeMultiprocessorCount, dev);
        hipOccupancyMaxActiveBlocksPerMultiprocessor(&per_cu, (const void*)fwd_kernel, NTHR, LDS_BYTES);
        if (per_cu < 1) { fprintf(stderr, "kernel_launch: occupancy query says %d blocks per CU\n", per_cu); per_cu = 1; }
        (void)hipGetLastError();
        grid = cus;
    }
    if (grid < 0) return;
    if (hipMemsetAsync((char*)d_ws + WS_CTL, 0, CTL_ZERO_BYTES, stream) != hipSuccess) { fprintf(stderr, "kernel_launch: hipMemsetAsync failed\n"); return; }
    Args a{};
    a.p.xp = (const float*)d_in[0]; a.p.xs = (const float*)d_in[1]; a.p.ck = (const float*)d_in[2]; a.p.cv = (const float*)d_in[3]; a.p.g_pre = (const float*)d_in[4];
    a.p.w_in = (const float*)d_in[5]; a.p.ln_g = (const float*)d_in[6]; a.p.ln_b = (const float*)d_in[7]; a.p.w_sp = (const float*)d_in[8]; a.p.b_sp = (const float*)d_in[9];
    a.p.sinks = (const float*)d_in[10]; a.p.w_pa = (const float*)d_in[11]; a.p.w_pb = (const float*)d_in[12]; a.p.w_out = (const float*)d_in[13]; a.p.g_post = (const float*)d_in[14];
    a.p.out = (float*)d_out; a.p.ws = (unsigned char*)d_ws;
#if MK_N_LAUNCHES == 1
    a.ph_lo = 0; a.ph_hi = 4;
    void* kargs[] = {&a};
    hipError_t e = hipLaunchCooperativeKernel((const void*)fwd_kernel, dim3(grid), dim3(NTHR), kargs, LDS_BYTES, stream);
    if (e != hipSuccess) fprintf(stderr, "kernel_launch: cooperative launch failed: %s (grid %d)\n", hipGetErrorString(e), grid);
#else
    for (int ph = 0; ph < 4; ++ph) { a.ph_lo = ph; a.ph_hi = ph + 1; hipLaunchKernelGGL(fwd_kernel, dim3(grid), dim3(NTHR), LDS_BYTES, stream, a); }
#endif
}
```

```cpp
#include <hip/hip_runtime.h>
#include <hip/hip_cooperative_groups.h>
#include <cstdio>
#include <cstdint>
namespace cg = cooperative_groups;

#ifndef MK_N_LAUNCHES
#define MK_N_LAUNCHES 1
#endif

namespace pg8 {
#define PG8_LAS __attribute__((address_space(3)))
typedef unsigned short bf16_t;
typedef short bf16x8 __attribute__((ext_vector_type(8)));
typedef float f32x4 __attribute__((ext_vector_type(4)));
typedef float f32x2 __attribute__((ext_vector_type(2)));
typedef unsigned u32x4 __attribute__((ext_vector_type(4)));
typedef unsigned u32x2 __attribute__((ext_vector_type(2)));
constexpr int BM = 256, BK = 64, HALF = 128, HTB = HALF * BK * 2  , STAGE_BYTES = 8 * HTB, NXCD = 8, WGM = 8;

__host__ __device__ __forceinline__ int lds_byte(int r, int c) { const int st = (r >> 4) * 2 + (c >> 5), rr = r & 15, cc = c & 31, ob = rr * 64 + cc * 2; return st * 1024 + (ob ^ (((ob >> 9) & 1) << 5)); }
__host__ __device__ __forceinline__ void stage_rc(int b, int& R, int& C) { const int st = b / 1024, sb = b % 1024, swz = sb ^ (((sb >> 9) & 1) << 5); R = (st >> 1) * 16 + swz / 64; C = (st & 1) * 32 + (swz % 64) / 2; }
__host__ __device__ __forceinline__ int perm32(int rho) { const int n = rho >> 4, i = rho & 15; return 8 * (i >> 2) + 4 * n + (i & 3); }

struct Unit { int pm, pn, kh, ty; };
constexpr size_t TSTEP = (size_t)256 * 2048 * 2;

struct StaticOrder {
    int nM, nN, nwg, G, c, nkh; const bf16_t *A0, *A1, *Bt0, *Bt1; int ntile;
    __device__ void init(int M, int N, int G_, int c_, int nkh_) { nM = M / BM; nN = N / BM; nwg = nM * nN; G = G_; c = c_; nkh = nkh_; }
    __device__ bool next(int i, Unit& u) const {
        const int ti = (nkh == 2) ? (i >> 1) : i; u.kh = (nkh == 2) ? (i & 1) : 0; u.ty = 0;
        const long L = (long)ti * G + c; if (L >= nwg) return false;
        int wgid = (int)L; { const int q = nwg / NXCD, r = nwg % NXCD, xcd = wgid % NXCD, off = wgid / NXCD; wgid = (xcd < r ? xcd * (q + 1) : r * (q + 1) + (xcd - r) * q) + off; }
        const int nig = WGM * nN, gid = wgid / nig, fm = gid * WGM, gsz = (nM - fm) < WGM ? (nM - fm) : WGM;
        u.pm = fm + ((wgid % nig) % gsz); u.pn = (wgid % nig) / gsz; return true;
    }
    __device__ __forceinline__ void operands(const Unit& u, const char*& A, const char*& B, int& nt) const {
        A = (const char*)(u.kh ? A1 : A0) + (size_t)u.pm * TSTEP; B = (const char*)(u.kh ? Bt1 : Bt0) + (size_t)u.pn * TSTEP; nt = ntile; }
    __device__ __forceinline__ void a_ready(const Unit&) const {}
    __device__ __forceinline__ void done(const Unit&) const {}
};

__device__ __forceinline__ unsigned cvt_pk_bf16(float lo, float hi) { unsigned r; asm volatile("v_cvt_pk_bf16_f32 %0, %1, %2" : "=v"(r) : "v"(lo), "v"(hi)); return r; }
__device__ __forceinline__ u32x4 pack8(f32x4 a, f32x4 b) { u32x4 w; w.x = cvt_pk_bf16(a[0], a[1]); w.y = cvt_pk_bf16(a[2], a[3]); w.z = cvt_pk_bf16(b[0], b[1]); w.w = cvt_pk_bf16(b[2], b[3]); return w; }
__device__ __forceinline__ float bf_lo(unsigned w) { return __uint_as_float(w << 16); }
__device__ __forceinline__ float bf_hi(unsigned w) { return __uint_as_float(w & 0xffff0000u); }
__device__ __forceinline__ f32x2 gelu_pk(f32x2 v) {
    const f32x2 av = __builtin_elementwise_abs(v), d = av * 0.2316418882f + 1.0f;
    f32x2 t; t.x = __builtin_amdgcn_rcpf(d.x); t.y = __builtin_amdgcn_rcpf(d.y);
    f32x2 q = t * 0.5307027145f + (-0.7265760135f); q = q * t + 0.7107068705f; q = q * t + (-0.142248368f); q = q * t + 0.127414796f; q = q * t;
    const f32x2 s = (v * v) * (-0.72134752044f);
    f32x2 e; e.x = __builtin_amdgcn_exp2f(s.x); e.y = __builtin_amdgcn_exp2f(s.y);
    const f32x2 m = v * (q * e), r = v - m;
    f32x2 o; o.x = v.x < 0.f ? m.x : r.x; o.y = v.y < 0.f ? m.y : r.y; return o;
}
__device__ __forceinline__ f32x4 gelu4(f32x4 v) { const f32x2 a = gelu_pk((f32x2){v[0], v[1]}), b = gelu_pk((f32x2){v[2], v[3]}); return (f32x4){a.x, a.y, b.x, b.y}; }
__device__ __forceinline__ float sigm(float x) { return __builtin_amdgcn_rcpf(1.0f + __builtin_amdgcn_exp2f(-1.4426950408889634f * x)); }
__device__ __forceinline__ f32x4 sigm4(f32x4 v) { return (f32x4){sigm(v[0]), sigm(v[1]), sigm(v[2]), sigm(v[3])}; }
__device__ __forceinline__ f32x4 silu4(f32x4 v) { return v * sigm4(v); }

template <class Epi, class Sched, bool ALIGN_EPI = false, bool SP2 = false>
__device__ __forceinline__ void gemm_phase(PG8_LAS unsigned char* lds, const Sched& S, const Epi& E) {
    const int tid = threadIdx.x, wid = __builtin_amdgcn_readfirstlane(tid >> 6), lane = tid & 63, wr = wid >> 2, wc = wid & 3, fr = lane & 15, fq = lane >> 4;
    int nt = 0; constexpr int lda = 2048, ldb = 2048;
    unsigned voffA[2], voffB[2];
#pragma unroll
    for (int i = 0; i < 2; ++i) { int R, C; stage_rc(tid * 16 + i * 8192, R, C); const int Rb = Epi::PERM ? ((R & ~31) + perm32(R & 31)) : R;
        voffA[i] = (unsigned)(R * lda + C) * 2u; voffB[i] = (unsigned)(Rb * ldb + C) * 2u; }
    const size_t kstep = (size_t)(BK * 2);
    const size_t hstepA = (size_t)HALF * lda * 2, hstepB = (size_t)HALF * ldb * 2;
    const size_t tstepA = 2 * hstepA, tstepB = 2 * hstepB;
    const unsigned ldsw = (unsigned)wid * 1024u;
    const int aoff = lds_byte(wr * 64 + fr, fq * 8), boff = lds_byte(wc * 32 + fr, fq * 8);
#define PG8_SA(b, h) (((b) * 2 + (h)) * HTB)
#define PG8_SB(b, h) ((4 + (b) * 2 + (h)) * HTB)
#define PG8_STAGE(bufoff, gbase, voff) do { _Pragma("unroll") for (int _i = 0; _i < 2; ++_i) \
        __builtin_amdgcn_global_load_lds((const unsigned*)((const char*)(gbase) + (voff)[_i]), (PG8_LAS unsigned*)(lds + (bufoff) + ldsw + _i * 8192), 16, 0, 0); } while (0)
#define PG8_LDA(dst, b, h) do { _Pragma("unroll") for (int m = 0; m < 4; ++m) _Pragma("unroll") for (int k = 0; k < 2; ++k) dst[m][k] = *(const PG8_LAS bf16x8*)(lds + PG8_SA(b, h) + aoff + m * 2048 + k * 1024); } while (0)
#define PG8_LDB(dst, b, h) do { _Pragma("unroll") for (int n = 0; n < 2; ++n) _Pragma("unroll") for (int k = 0; k < 2; ++k) dst[n][k] = *(const PG8_LAS bf16x8*)(lds + PG8_SB(b, h) + boff + n * 2048 + k * 1024); } while (0)
#define PG8_MMA(ai, bj, At, Bt) do { __builtin_amdgcn_s_setprio(1); _Pragma("unroll") for (int m = 0; m < 4; ++m) _Pragma("unroll") for (int n = 0; n < 2; ++n) _Pragma("unroll") for (int k = 0; k < 2; ++k) \
        acc[ai][bj][m][n] = __builtin_amdgcn_mfma_f32_16x16x32_bf16(Bt[n][k], At[m][k], acc[ai][bj][m][n], 0, 0, 0); __builtin_amdgcn_s_setprio(0); } while (0)
#define PG8_WAIT_V(n) asm volatile("s_waitcnt vmcnt(" #n ")" ::: "memory")
#define PG8_WAIT_L(n) asm volatile("s_waitcnt lgkmcnt(" #n ")" ::: "memory")
#define PG8_BAR __builtin_amdgcn_s_barrier()
#define PG8_SCHED __builtin_amdgcn_sched_barrier(0)
    Unit cur, nxt; int ui = 0;
    if (!S.next(0, cur)) return;
    f32x4 acc[2][2][4][2];
#pragma unroll
    for (int a = 0; a < 2; ++a)
#pragma unroll
        for (int b = 0; b < 2; ++b)
#pragma unroll
            for (int m = 0; m < 4; ++m)
#pragma unroll
                for (int n = 0; n < 2; ++n) acc[a][b][m][n] = (f32x4){0.f, 0.f, 0.f, 0.f};
    bf16x8 At[4][2], B0[2][2], B1[2][2];
    const char* cA; const char* cB; S.operands(cur, cA, cB, nt);
    S.a_ready(cur);
    if constexpr (SP2) {
        PG8_STAGE(PG8_SB(0, 0), cB, voffB); PG8_STAGE(PG8_SB(0, 1), cB + hstepB, voffB); PG8_STAGE(PG8_SA(0, 0), cA, voffA); PG8_STAGE(PG8_SA(0, 1), cA + hstepA, voffA);
        if (wr == 1) PG8_BAR;
        PG8_WAIT_V(2); PG8_BAR;
        PG8_STAGE(PG8_SB(1, 0), cB + kstep, voffB); PG8_STAGE(PG8_SA(1, 0), cA + kstep, voffA); PG8_STAGE(PG8_SB(1, 1), cB + hstepB + kstep, voffB);
        PG8_WAIT_V(6); PG8_BAR;
    } else {
        PG8_STAGE(PG8_SB(0, 0), cB, voffB); PG8_STAGE(PG8_SA(0, 0), cA, voffA); PG8_STAGE(PG8_SB(0, 1), cB + hstepB, voffB); PG8_STAGE(PG8_SA(0, 1), cA + hstepA, voffA);
        if (wr == 1) PG8_BAR;
        PG8_WAIT_V(4); PG8_BAR;
        PG8_STAGE(PG8_SB(1, 0), cB + kstep, voffB); PG8_STAGE(PG8_SA(1, 0), cA + kstep, voffA); PG8_STAGE(PG8_SB(1, 1), cB + hstepB + kstep, voffB);
        PG8_WAIT_V(6); PG8_BAR;
    }
    for (;;) {
        const bool has_next = S.next(ui + 1, nxt);
        const char* nA = cA; const char* nB = cB; int nnt = nt; if (has_next) S.operands(nxt, nA, nB, nnt);
        for (int t = 0; t < nt; t += 2) {
            const bool last = (t == nt - 2);
            const char* a1 = cA + (size_t)(t + 1) * kstep;
            const char* a2 = last ? nA : cA + (size_t)(t + 2) * kstep; const char* b2 = last ? nB : cB + (size_t)(t + 2) * kstep;
            const char* a3 = a2 + kstep; const char* b3 = b2 + kstep;
            if (last && has_next) S.a_ready(nxt);
            if constexpr (SP2) {
            PG8_LDB(B0, 0, 0); PG8_LDB(B1, 0, 1); PG8_SCHED; PG8_LDA(At, 0, 0); PG8_STAGE(PG8_SA(1, 1), a1 + hstepA, voffA);
            PG8_WAIT_V(8); PG8_WAIT_L(0); PG8_BAR; PG8_MMA(0, 0, At, B0); PG8_MMA(0, 1, At, B1); PG8_BAR; PG8_SCHED;
            PG8_LDA(At, 0, 1); PG8_STAGE(PG8_SB(0, 0), b2, voffB); PG8_STAGE(PG8_SB(0, 1), b2 + hstepB, voffB); PG8_STAGE(PG8_SA(0, 0), a2, voffA);
            PG8_WAIT_V(8); PG8_WAIT_L(0); PG8_BAR; PG8_MMA(1, 0, At, B0); PG8_MMA(1, 1, At, B1); PG8_BAR; PG8_SCHED;
            PG8_LDB(B0, 1, 0); PG8_LDB(B1, 1, 1); PG8_SCHED; PG8_LDA(At, 1, 0); PG8_STAGE(PG8_SA(0, 1), a2 + hstepA, voffA);
            PG8_WAIT_V(8); PG8_WAIT_L(0); PG8_BAR; PG8_MMA(0, 0, At, B0); PG8_MMA(0, 1, At, B1); PG8_BAR; PG8_SCHED;
            PG8_LDA(At, 1, 1); PG8_STAGE(PG8_SB(1, 0), b3, voffB); PG8_STAGE(PG8_SB(1, 1), b3 + hstepB, voffB); PG8_STAGE(PG8_SA(1, 0), a3, voffA);
            PG8_WAIT_V(8); PG8_WAIT_L(0); PG8_BAR; PG8_MMA(1, 0, At, B0); PG8_MMA(1, 1, At, B1); PG8_BAR; PG8_SCHED;
            } else {
            PG8_LDB(B0, 0, 0); PG8_SCHED; PG8_LDA(At, 0, 0); PG8_STAGE(PG8_SA(1, 1), a1 + hstepA, voffA);
            PG8_WAIT_L(8); PG8_BAR; PG8_WAIT_L(0); PG8_MMA(0, 0, At, B0); PG8_BAR; PG8_SCHED;
            PG8_LDB(B1, 0, 1); PG8_STAGE(PG8_SB(0, 0), b2, voffB);
            PG8_BAR; PG8_WAIT_L(0); PG8_MMA(0, 1, At, B1); PG8_BAR;
            PG8_LDA(At, 0, 1); PG8_STAGE(PG8_SA(0, 0), a2, voffA);
            PG8_BAR; PG8_WAIT_L(0); PG8_MMA(1, 0, At, B0); PG8_BAR; PG8_SCHED;
            PG8_STAGE(PG8_SB(0, 1), b2 + hstepB, voffB);
            PG8_WAIT_V(6); PG8_BAR; PG8_MMA(1, 1, At, B1); PG8_BAR;
            PG8_LDB(B0, 1, 0); PG8_SCHED; PG8_LDA(At, 1, 0); PG8_STAGE(PG8_SA(0, 1), a2 + hstepA, voffA);
            PG8_WAIT_L(8); PG8_BAR; PG8_WAIT_L(0); PG8_MMA(0, 0, At, B0); PG8_BAR; PG8_SCHED;
            PG8_LDB(B1, 1, 1); PG8_STAGE(PG8_SB(1, 0), b3, voffB);
            PG8_BAR; PG8_WAIT_L(0); PG8_MMA(0, 1, At, B1); PG8_BAR;
            PG8_LDA(At, 1, 1); PG8_STAGE(PG8_SA(1, 0), a3, voffA);
            PG8_BAR; PG8_WAIT_L(0); PG8_MMA(1, 0, At, B0); PG8_BAR; PG8_SCHED;
            PG8_STAGE(PG8_SB(1, 1), b3 + hstepB, voffB);
            PG8_WAIT_V(6); PG8_BAR; PG8_MMA(1, 1, At, B1); PG8_BAR;
            }
        }
        if constexpr (ALIGN_EPI) { if (wr == 0) PG8_BAR; }
        if constexpr (!Epi::AFTER_DRAIN) { E(acc, cur, wr, wc, fr, fq); S.done(cur); }
        if (!has_next) break;
        if (Epi::zero_after(cur)) {
#pragma unroll
        for (int a = 0; a < 2; ++a)
#pragma unroll
            for (int b = 0; b < 2; ++b)
#pragma unroll
                for (int m = 0; m < 4; ++m)
#pragma unroll
                    for (int n = 0; n < 2; ++n) acc[a][b][m][n] = (f32x4){0.f, 0.f, 0.f, 0.f};
        }
        cur = nxt; cA = nA; cB = nB; nt = nnt; ++ui;
        if constexpr (ALIGN_EPI) { if (wr == 1) PG8_BAR; }
    }
    PG8_WAIT_V(0);
    if constexpr (!ALIGN_EPI) { if (wr == 0) PG8_BAR; }
    PG8_BAR;
    if constexpr (Epi::AFTER_DRAIN) { E.fused(acc, cur, wr, wc, fr, fq, lds, wid, lane); S.done(cur); }
#undef PG8_SA
#undef PG8_SB
#undef PG8_STAGE
#undef PG8_LDA
#undef PG8_LDB
#undef PG8_MMA
#undef PG8_WAIT_V
#undef PG8_WAIT_L
#undef PG8_BAR
#undef PG8_SCHED
}}

using pg8::bf16_t; using pg8::bf16x8; using pg8::f32x4; using pg8::f32x2; using pg8::u32x4; using pg8::u32x2; using pg8::Unit;
#define LAS __attribute__((address_space(3)))
typedef short s16x4 __attribute__((ext_vector_type(4)));

constexpr int NWAVES = 8, NTHR = 512;
constexpr int DM = 2048, NB = 8, SEQ = 2048, DB = 128, DS = 8, PAST = 8192;
constexpr int MP = NB * SEQ, MS = DB * DS, M = MP + MS;
constexpr int AW = 1024, NG = 8, CH = 128, HD = 64, NH = 16, NKV = 4, BW = 1024, KVW = 256, WIN = 128;
constexpr int INC = 3 * AW + 2 * BW + 2 * KVW + 2 * DM;
constexpr int Z1W = 5632, GW = 4096;
constexpr int C_U = 0, C_V = 1024, C_ZA = 2048, C_Q = 3072, C_K = 4096, C_VA = 4352, C_ZB = 4608;
constexpr float EPS = 1e-6f;
constexpr float QSCALE = 0.125f * 1.4426950408889634f;
constexpr float LOG2E = 1.4426950408889634f;
constexpr int NTPOS = SEQ + DS;

constexpr size_t O_Y = 0, O_KWP = (size_t)M * DM, O_VWP = O_KWP + (size_t)NB * WIN * KVW, O_KWS = O_VWP + (size_t)NB * WIN * KVW,
                 O_VWS = O_KWS + (size_t)DB * WIN * KVW, O_CV = O_VWS + (size_t)DB * WIN * KVW, O_END = O_CV + (size_t)MS * AW;

constexpr size_t al256(size_t x) { return (x + 255) & ~(size_t)255; }
constexpr size_t WS_CTL = 0, CTL_ZERO_BYTES = 16384;
constexpr size_t WS_ROPE = CTL_ZERO_BYTES;
constexpr size_t WS_STATS = al256(WS_ROPE + (size_t)NTPOS * 32 * 2 * 4);
constexpr size_t WS_SSQ = al256(WS_STATS + (size_t)M * 32 * 4);
constexpr size_t WS_WIN = al256(WS_SSQ + (size_t)M * 32 * 4);
constexpr size_t WS_WP = al256(WS_WIN + (size_t)INC * DM * 2);
constexpr size_t WS_WOUT = al256(WS_WP + (size_t)DM * 2048 * 2);
constexpr size_t WS_H = al256(WS_WOUT + (size_t)DM * DM * 2);
constexpr size_t WS_Z1 = al256(WS_H + (size_t)M * DM * 2);
constexpr size_t WS_G = al256(WS_Z1 + (size_t)M * Z1W * 2);
constexpr size_t WS_END = al256(WS_G + (size_t)M * GW * 2);

constexpr int LDS_BYTES = 139264;

enum { T_U = 0, T_V, T_ZA, T_Q, T_K, T_VA, T_ZB, T_G };
struct EpiIn {
    static constexpr bool PERM = true, AFTER_DRAIN = false;
    static __device__ __forceinline__ bool zero_after(const Unit&) { return true; }
    bf16_t* Z1; bf16_t* G; float* stats; const float* rope; float* out;
    template <int TY> __device__ __forceinline__ void tile(f32x4 (&acc)[2][2][4][2], const Unit& u, int wr, int wc, int fr, int fq) const {
        const int cl = wc * 32 + 8 * fq; const int i0 = (16 * wc + 4 * fq) & 31;
        f32x4 rcs[2][4][2];
        if (TY == T_Q || TY == T_K) {
#pragma unroll
            for (int ai = 0; ai < 2; ++ai)
#pragma unroll
                for (int m = 0; m < 4; ++m) { const int row = u.pm * 256 + ai * 128 + wr * 64 + m * 16 + fr;
                    const int tpos = row < MP ? (row & (SEQ - 1)) : SEQ + ((row - MP) & (DS - 1));
                    const f32x4* rp = (const f32x4*)(rope + ((size_t)tpos * 32 + i0) * 2); rcs[ai][m][0] = rp[0]; rcs[ai][m][1] = rp[1]; }
        }
#pragma unroll
        for (int ai = 0; ai < 2; ++ai)
#pragma unroll
            for (int m = 0; m < 4; ++m) {
                const int row = u.pm * 256 + ai * 128 + wr * 64 + m * 16 + fr;
                f32x4 rc0 = {0.f, 0.f, 0.f, 0.f}, rc1 = {0.f, 0.f, 0.f, 0.f};
                if (TY == T_Q || TY == T_K) { rc0 = rcs[ai][m][0]; rc1 = rcs[ai][m][1]; }
                float ss = 0.f, sq = 0.f;
                bool win = false; size_t wbase = 0; float* wk = nullptr;
                if (TY == T_K || TY == T_VA) {
                    if (row < MP) { const int t = row & (SEQ - 1); win = t >= SEQ - WIN; wbase = ((size_t)(row >> 11) * WIN + (t - (SEQ - WIN))) * KVW; wk = out + (TY == T_K ? O_KWP : O_VWP); }
                    else { const int r = row - MP; win = true; wbase = ((size_t)(r >> 3) * WIN + (WIN - DS) + (r & 7)) * KVW; wk = out + (TY == T_K ? O_KWS : O_VWS); }
                }
#pragma unroll
                for (int bj = 0; bj < 2; ++bj) {
                    f32x4 a = acc[ai][bj][m][0], b = acc[ai][bj][m][1];
                    const int col = u.pn * 256 + bj * 128 + cl;
                    if (TY == T_U || TY == T_V) { a = pg8::gelu4(a); b = pg8::gelu4(b); }
                    if (TY == T_V) { ss += (a[0] + a[1]) + (a[2] + a[3]) + (b[0] + b[1]) + (b[2] + b[3]);
                        sq += (a[0] * a[0] + a[1] * a[1]) + (a[2] * a[2] + a[3] * a[3]) + (b[0] * b[0] + b[1] * b[1]) + (b[2] * b[2] + b[3] * b[3]); }
                    if (TY == T_ZA || TY == T_ZB) { a = pg8::silu4(a); b = pg8::silu4(b); }
                    if (TY == T_G) { a = pg8::sigm4(a); b = pg8::sigm4(b); }
                    if (TY == T_Q || TY == T_K) {
                        f32x4 ra, rb;
                        ra[0] = a[0] * rc0[0] - a[1] * rc0[1]; ra[1] = a[1] * rc0[0] + a[0] * rc0[1];
                        ra[2] = a[2] * rc0[2] - a[3] * rc0[3]; ra[3] = a[3] * rc0[2] + a[2] * rc0[3];
                        rb[0] = b[0] * rc1[0] - b[1] * rc1[1]; rb[1] = b[1] * rc1[0] + b[0] * rc1[1];
                        rb[2] = b[2] * rc1[2] - b[3] * rc1[3]; rb[3] = b[3] * rc1[2] + b[2] * rc1[3];
                        a = ra; b = rb;
                        if (TY == T_Q) { a = a * QSCALE; b = b * QSCALE; }
                    }
                    if (TY == T_K) { if (win) { float* o = wk + wbase + (bj * 2 + (wc >> 1)) * HD + i0;
                        *(f32x4*)o = (f32x4){a[0], a[2], b[0], b[2]}; *(f32x4*)(o + 32) = (f32x4){a[1], a[3], b[1], b[3]}; } }
                    if (TY == T_VA) { if (win) { float* o = wk + wbase + (bj * 2 + (wc >> 1)) * HD + (cl & 63); *(f32x4*)o = a; *(f32x4*)(o + 4) = b; } }
                    const u32x4 w = pg8::pack8(a, b);
                    if (TY == T_G) *(u32x4*)(G + (size_t)row * GW + (col - Z1W)) = w;
                    else *(u32x4*)(Z1 + (size_t)row * Z1W + col) = w;
                }
                if (TY == T_V) {
                    ss += __shfl_xor(ss, 16); ss += __shfl_xor(ss, 32); sq += __shfl_xor(sq, 16); sq += __shfl_xor(sq, 32);
                    if (fq == 0) *(f32x2*)(stats + ((size_t)row * 16 + (u.pn - 4) * 4 + wc) * 2) = (f32x2){ss, sq};
                }
            }
    }
    __device__ __forceinline__ void tile_gate(f32x4 (&acc)[2][2][4][2], const Unit& u, int wr, int wc, int fr, int fq) const {
        const int c = (u.pn - 22) * 128 + wc * 32 + 8 * fq;
#pragma unroll
        for (int ai = 0; ai < 2; ++ai)
#pragma unroll
            for (int m = 0; m < 4; ++m) {
                const int row = u.pm * 256 + ai * 128 + wr * 64 + m * 16 + fr;
                const f32x4 sa0 = pg8::sigm4(acc[ai][0][m][0]), sa1 = pg8::sigm4(acc[ai][0][m][1]), sb0 = pg8::sigm4(acc[ai][1][m][0]), sb1 = pg8::sigm4(acc[ai][1][m][1]);
                f32x4 r0, r1;
#pragma unroll
                for (int j = 0; j < 4; ++j) { r0[j] = sa0[j] * __builtin_amdgcn_rcpf(sb0[j]); r1[j] = sa1[j] * __builtin_amdgcn_rcpf(sb1[j]); }
                bf16_t* o = G + (size_t)row * GW + c;
                *(u32x4*)o = pg8::pack8(r0, r1); *(u32x4*)(o + DM) = pg8::pack8(sb0, sb1);
            }
    }
    __device__ __forceinline__ void operator()(f32x4 (&acc)[2][2][4][2], const Unit& u, int wr, int wc, int fr, int fq) const {
        asm volatile("" : "+v"(fr), "+v"(fq));
        const int pn = u.pn;
        if (pn < 4) tile<T_U>(acc, u, wr, wc, fr, fq);
        else if (pn < 8) tile<T_V>(acc, u, wr, wc, fr, fq);
        else if (pn < 12) tile<T_ZA>(acc, u, wr, wc, fr, fq);
        else if (pn < 16) tile<T_Q>(acc, u, wr, wc, fr, fq);
        else if (pn == 16) tile<T_K>(acc, u, wr, wc, fr, fq);
        else if (pn == 17) tile<T_VA>(acc, u, wr, wc, fr, fq);
        else if (pn < 22) tile<T_ZB>(acc, u, wr, wc, fr, fq);
        else tile_gate(acc, u, wr, wc, fr, fq);
    }
};
__device__ __forceinline__ void unpack8(u32x4 w, f32x4& a, f32x4& b) {
    a = (f32x4){pg8::bf_lo(w.x), pg8::bf_hi(w.x), pg8::bf_lo(w.y), pg8::bf_hi(w.y)}; b = (f32x4){pg8::bf_lo(w.z), pg8::bf_hi(w.z), pg8::bf_lo(w.w), pg8::bf_hi(w.w)};
}
__device__ __forceinline__ void store16_sc1(void* p, u32x4 v) { asm volatile("global_store_dwordx4 %0, %1, off sc1" :: "v"(p), "v"(v) : "memory"); }
struct EpiMerge {
    const bf16_t* G; bf16_t* MG; unsigned* mgcnt;
    __device__ __forceinline__ void operator()(f32x4 (&acc)[2][2][4][2], const Unit& u, int wr, int wc, int fr, int fq) const {
        asm volatile("" : "+v"(fr), "+v"(fq));
        const int cl = wc * 32 + 8 * fq; const int row0 = u.pm * 256 + wr * 64 + fr;
        const bf16_t* gp = G + (size_t)row0 * GW + u.pn * 256 + cl;
        if (u.kh == 0) {
#pragma unroll
            for (int ai = 0; ai < 2; ++ai)
#pragma unroll
                for (int m = 0; m < 4; ++m)
#pragma unroll
                    for (int bj = 0; bj < 2; ++bj) {
                        const bf16_t* p = gp + (size_t)(ai * 128 + m * 16) * GW + bj * 128;
                        f32x4 r0, r1; unpack8(*(const u32x4*)p, r0, r1);
                        acc[ai][bj][m][0] *= r0; acc[ai][bj][m][1] *= r1;
                    }
        } else {
            u32x4 sbw[2][4][2];
#pragma unroll
            for (int ai = 0; ai < 2; ++ai)
#pragma unroll
                for (int m = 0; m < 4; ++m)
#pragma unroll
                    for (int bj = 0; bj < 2; ++bj) sbw[ai][m][bj] = *(const u32x4*)(gp + (size_t)(ai * 128 + m * 16) * GW + bj * 128 + DM);
            asm volatile("" ::: "memory");
            bf16_t* op = MG + (size_t)row0 * DM + u.pn * 256 + cl;
#pragma unroll
            for (int ai = 0; ai < 2; ++ai)
#pragma unroll
                for (int m = 0; m < 4; ++m)
#pragma unroll
                    for (int bj = 0; bj < 2; ++bj) { f32x4 sb0, sb1; unpack8(sbw[ai][m][bj], sb0, sb1);
                        *(u32x4*)(op + (size_t)(ai * 128 + m * 16) * DM + bj * 128) = pg8::pack8(acc[ai][bj][m][0] * sb0, acc[ai][bj][m][1] * sb1); }
            asm volatile("s_waitcnt vmcnt(0)" ::: "memory");
            if (fr == 0 && fq == 0) (void)__hip_atomic_fetch_add(mgcnt + 64 * u.pm, 1u, __ATOMIC_RELAXED, __HIP_MEMORY_SCOPE_AGENT);
        }
    }
};
struct EpiOutNorm {
    const float* xp; const float* xs; const float* g_post; float* Y; unsigned* rowss;
    template <int B> __device__ __forceinline__ void ldx(f32x4 (&xb)[2][2], const float* Xl) const {
#pragma unroll
        for (int bj = 0; bj < 2; ++bj) { const float* p = Xl + (size_t)((B >> 2) * 128 + (B & 3) * 16) * DM + bj * 128; xb[bj][0] = *(const f32x4*)p; xb[bj][1] = *(const f32x4*)(p + 4); }
    }
    template <int B> __device__ __forceinline__ void stx(const f32x4 (&xb)[2][2], f32x4 (&acc)[2][2][4][2], float* Yl, const float (&rstd)[8], const f32x4 (&gv)[2][2]) const {
#pragma unroll
        for (int bj = 0; bj < 2; ++bj) { constexpr int ai = B >> 2, m = B & 3; float* o = Yl + (size_t)(ai * 128 + m * 16) * DM + bj * 128; const float r = rstd[B];
            *(f32x4*)o = xb[bj][0] + acc[ai][bj][m][0] * r * gv[bj][0]; *(f32x4*)(o + 4) = xb[bj][1] + acc[ai][bj][m][1] * r * gv[bj][1]; }
    }
    __device__ __forceinline__ void operator()(f32x4 (&acc)[2][2][4][2], const Unit& u, int wr, int wc, int fr, int fq) const {
        asm volatile("" : "+v"(fr), "+v"(fq));
        const int cl = wc * 32 + 8 * fq; const int rbase = u.pm * 256 + wr * 64 + fr;
        const float* X = (u.pm < MP / 256) ? xp + (size_t)u.pm * 256 * DM : xs + (size_t)(u.pm - MP / 256) * 256 * DM;
        const float* Xl = X + (size_t)(wr * 64 + fr) * DM + u.pn * 256 + cl; float* Yl = Y + (size_t)rbase * DM + u.pn * 256 + cl;
        f32x4 xb0[2][2], xb1[2][2], xb2[2][2];
        ldx<0>(xb0, Xl);
        f32x4 gv[2][2];
#pragma unroll
        for (int bj = 0; bj < 2; ++bj) { gv[bj][0] = *(const f32x4*)(g_post + u.pn * 256 + bj * 128 + cl); gv[bj][1] = *(const f32x4*)(g_post + u.pn * 256 + bj * 128 + cl + 4); }
        unsigned long long* rs = (unsigned long long*)rowss + rbase;
#pragma unroll
        for (int ai = 0; ai < 2; ++ai)
#pragma unroll
            for (int m = 0; m < 4; ++m) {
                float sq = 0.f;
#pragma unroll
                for (int bj = 0; bj < 2; ++bj) { const f32x4 a = acc[ai][bj][m][0], b = acc[ai][bj][m][1];
                    sq += (a[0] * a[0] + a[1] * a[1]) + (a[2] * a[2] + a[3] * a[3]) + (b[0] * b[0] + b[1] * b[1]) + (b[2] * b[2] + b[3] * b[3]); }
                sq += __shfl_xor(sq, 16); sq += __shfl_xor(sq, 32);
                if (fq == 0) (void)__hip_atomic_fetch_add(rs + ai * 128 + m * 16, (1ull << 56) + (unsigned long long)(sq * 16777216.0f + 0.5f), __ATOMIC_RELAXED, __HIP_MEMORY_SCOPE_AGENT);
            }
        float rstd[8];
        { unsigned long long v[8]; unsigned spins = 0;
          for (;;) { bool ok = true;
#pragma unroll
              for (int i = 0; i < 8; ++i) { v[i] = __hip_atomic_load(rs + (i >> 2) * 128 + (i & 3) * 16, __ATOMIC_RELAXED, __HIP_MEMORY_SCOPE_AGENT); ok = ok && ((v[i] >> 56) == 32ull); }
              if (__all(ok) || ++spins > (1u << 17)) break;
              __builtin_amdgcn_s_sleep(1); }
#pragma unroll
          for (int i = 0; i < 8; ++i) rstd[i] = __builtin_amdgcn_rsqf((float)(v[i] & ((1ull << 56) - 1)) * (1.0f / (16777216.0f * DM)) + EPS); }
#define FENCE_ asm volatile("" ::: "memory")
        ldx<1>(xb1, Xl); ldx<2>(xb2, Xl); FENCE_; stx<0>(xb0, acc, Yl, rstd, gv); FENCE_;
        ldx<3>(xb0, Xl); FENCE_; stx<1>(xb1, acc, Yl, rstd, gv); FENCE_;
        ldx<4>(xb1, Xl); FENCE_; stx<2>(xb2, acc, Yl, rstd, gv); FENCE_;
        ldx<5>(xb2, Xl); FENCE_; stx<3>(xb0, acc, Yl, rstd, gv); FENCE_;
        ldx<6>(xb0, Xl); FENCE_; stx<4>(xb1, acc, Yl, rstd, gv); FENCE_;
        ldx<7>(xb1, Xl); FENCE_; stx<5>(xb2, acc, Yl, rstd, gv); FENCE_;
        stx<6>(xb0, acc, Yl, rstd, gv); stx<7>(xb1, acc, Yl, rstd, gv);
#undef FENCE_
    }
};

struct MOOrder {
    int c; const bf16_t *AB, *WpT, *MG, *WoutT; const unsigned* mgcnt;
    __device__ bool next(int i, Unit& u) const {
        const int j = c >> 3; u.pn = c & 7;
        const int n3 = ((j & 3) == 0 && j < 16) ? 3 : 2, n4 = ((j & 3) == 1 && j < 16) ? 3 : 2;
        if (i < 2 * n3) { const int t = i >> 1; u.kh = i & 1; u.ty = 0; u.pm = (t < 2) ? j + 32 * t : 64 + (j >> 2); return true; }
        const int k = i - 2 * n3; if (k >= n4) return false;
        u.kh = 0; u.ty = 1; u.pm = (k < 2) ? j + 32 * k : 64 + (j >> 2); return true;
    }
    __device__ __forceinline__ void operands(const Unit& u, const char*& A, const char*& B, int& nt) const {
        if (u.ty == 0) { A = (const char*)(AB + u.kh * AW) + (size_t)u.pm * pg8::TSTEP; B = (const char*)(WpT + u.kh * AW) + (size_t)u.pn * pg8::TSTEP; nt = AW / 64; }
        else { A = (const char*)MG + (size_t)u.pm * pg8::TSTEP; B = (const char*)WoutT + (size_t)u.pn * pg8::TSTEP; nt = DM / 64; }
    }
    __device__ __forceinline__ void a_ready(const Unit& u) const {
        if (u.ty != 1) return;
        if (threadIdx.x < 64) {
            unsigned spins = 0;
            while ((unsigned)__builtin_amdgcn_readfirstlane(__hip_atomic_load(mgcnt + 64 * u.pm, __ATOMIC_RELAXED, __HIP_MEMORY_SCOPE_AGENT)) < 64u) { __builtin_amdgcn_s_sleep(2); if (++spins > (1u << 17)) break; }
            __builtin_amdgcn_fence(__ATOMIC_ACQUIRE, "agent");
            asm volatile("s_waitcnt vmcnt(0)" ::: "memory");
        }
        asm volatile("" ::: "memory"); __builtin_amdgcn_s_barrier(); asm volatile("" ::: "memory");
    }
    __device__ __forceinline__ void done(const Unit&) const {}
};
struct EpiMO {
    static constexpr bool PERM = true, AFTER_DRAIN = false;
    static __device__ __forceinline__ bool zero_after(const Unit& u) { return u.ty == 1 || u.kh == 1; }
    EpiMerge em; EpiOutNorm eo;
    __device__ __forceinline__ void operator()(f32x4 (&acc)[2][2][4][2], const Unit& u, int wr, int wc, int fr, int fq) const {
        if (u.ty == 0) em(acc, u, wr, wc, fr, fq); else eo(acc, u, wr, wc, fr, fq);
    }
};
#define XB_TMO      128
#define XB_XCNT(j)  (256  + 64 * (j))
#define XB_XSUB(j)  (1280 + 64 * (j))
#define XB_XGEN(j)  (2304 + 64 * (j))
#define XB_TOP      3328
#define XB_TOPGEN   3392
#define XCD_BAR_WORDS 3456
#define XB_SPIN_CAP (1u << 18)

__device__ __forceinline__ unsigned xb_ld(unsigned* p)              { return __hip_atomic_load(p, __ATOMIC_RELAXED, __HIP_MEMORY_SCOPE_AGENT); }
__device__ __forceinline__ unsigned xb_add(unsigned* p, unsigned v) { return __hip_atomic_fetch_add(p, v, __ATOMIC_RELAXED, __HIP_MEMORY_SCOPE_AGENT); }
__device__ __forceinline__ unsigned xb_xcc_id() { return (unsigned)__builtin_amdgcn_s_getreg((3 << 11) | 20) & 0xFu; }
#define XB_SPIN(cond, bar) do { unsigned _sp = 0; while (cond) { __builtin_amdgcn_s_sleep(1); \
    if ((++_sp & 255u) == 0u) { if (xb_ld(&(bar)[XB_TMO])) break; if (_sp > XB_SPIN_CAP) { atomicAdd(&(bar)[XB_TMO], 1u); break; } } } } while (0)

struct XcdBarrier {
    unsigned* bar; unsigned x;
    volatile LAS unsigned* st;
};

__device__ __forceinline__ XcdBarrier xcd_barrier_post(unsigned* bar, volatile LAS unsigned* st) {
    XcdBarrier b; b.bar = bar; b.x = xb_xcc_id(); b.st = st;
    if (threadIdx.x == 0) st[2] = xb_add(&bar[XB_XCNT(b.x)], 1u);
    return b;
}
__device__ __forceinline__ void xcd_barrier_complete(unsigned* bar, unsigned x, unsigned& nloc, unsigned& nx) {
    const unsigned G = gridDim.x * gridDim.y * gridDim.z;
    unsigned sum, cnt, mine, sp = 0u;
    for (;;) {
        sum = 0u; cnt = 0u; mine = 0u;
#pragma unroll
        for (unsigned j = 0; j < 16; ++j) { const unsigned c = xb_ld(&bar[XB_XCNT(j)]); sum += c; cnt += (c > 0u) ? 1u : 0u; mine = (j == x) ? c : mine; }
        if (sum == G) break;
        __builtin_amdgcn_s_sleep(1);
        if ((++sp & 255u) == 0u) { if (xb_ld(&bar[XB_TMO])) break; if (sp > XB_SPIN_CAP) { atomicAdd(&bar[XB_TMO], 1u); break; } }
    }
    nloc = mine > 0u ? mine : 1u; nx = cnt > 0u ? cnt : 1u;
}

__device__ __forceinline__ void xcd_barrier(const XcdBarrier& b) {
    asm volatile("s_waitcnt vmcnt(0)" ::: "memory");
    __syncthreads();
    if (threadIdx.x == 0) {
        unsigned* bar = b.bar;
        __builtin_amdgcn_s_waitcnt(0);
        unsigned nloc = b.st[0], nx = b.st[1];
        if (nloc == 0u) { xcd_barrier_complete(bar, b.x, nloc, nx); b.st[0] = nloc; b.st[1] = nx; }
        const unsigned old = xb_add(&bar[XB_XSUB(b.x)], 1u);
        const unsigned gen = old / nloc;
        if (old + 1u == (gen + 1u) * nloc) {
            __builtin_amdgcn_fence(__ATOMIC_RELEASE, "agent");
            asm volatile("s_waitcnt vmcnt(0)" ::: "memory");
            const unsigned og = xb_add(&bar[XB_TOP], 1u);
            const unsigned tg = og / nx;
            if (og + 1u == (tg + 1u) * nx) xb_add(&bar[XB_TOPGEN], 1u);
            else XB_SPIN(xb_ld(&bar[XB_TOPGEN]) == tg, bar);
            __builtin_amdgcn_fence(__ATOMIC_ACQUIRE, "agent");
            xb_add(&bar[XB_XGEN(b.x)], 1u);
            asm volatile("s_waitcnt vmcnt(0)" ::: "memory");
        } else {
            XB_SPIN(xb_ld(&bar[XB_XGEN(b.x)]) == gen, bar);
            __builtin_amdgcn_fence(__ATOMIC_ACQUIRE, "agent");
            asm volatile("s_waitcnt vmcnt(0)" ::: "memory");
        }
    }
    __syncthreads();
}

__device__ __forceinline__ float wave_sum(float v) {
#pragma unroll
    for (int o = 1; o < 64; o <<= 1) v += __shfl_xor(v, o);
    return v;
}
__device__ __forceinline__ unsigned f2bf(float f) { unsigned u = __float_as_uint(f); return (u + 0x7fffu + ((u >> 16) & 1u)) >> 16; }
__device__ __forceinline__ unsigned pk2(float lo, float hi) { return pg8::cvt_pk_bf16(lo, hi); }
__device__ __forceinline__ bf16_t pick16(u32x4 v, int idx) { const unsigned d01 = (idx & 2) ? v.y : v.x, d23 = (idx & 2) ? v.w : v.z, d = (idx & 4) ? d23 : d01; return (bf16_t)((idx & 1) ? (d >> 16) : (d & 0xffffu)); }
#define LDS_WAIT() asm volatile("s_waitcnt lgkmcnt(0)" ::: "memory")

struct Ptrs {
    const float *xp, *xs, *ck, *cv, *g_pre, *w_in, *ln_g, *ln_b, *w_sp, *b_sp, *sinks, *w_pa, *w_pb, *w_out, *g_post;
    float* out; unsigned char* ws;
};
static __device__ const double kInvFreq[32] = {1.0, 0.7498942093324559, 0.5623413251903491, 0.4216965034285822, 0.31622776601683794, 0.23713737056616552, 0.1778279410038923, 0.1333521432163324, 0.1, 0.07498942093324558, 0.05623413251903491, 0.042169650342858224, 0.03162277660168379, 0.023713737056616554, 0.01778279410038923, 0.01333521432163324, 0.01, 0.007498942093324558, 0.005623413251903491, 0.004216965034285823, 0.0031622776601683794, 0.0023713737056616554, 0.0017782794100389228, 0.001333521432163324, 0.001, 0.0007498942093324559, 0.0005623413251903491, 0.00042169650342858224, 0.00031622776601683794, 0.00023713737056616554, 0.00017782794100389227, 0.0001333521432163324};

template <bool QKPERM>
__device__ __forceinline__ void p0_transpose_item(const float* W, int N, bf16_t* WT, int ldt, int koff, LAS float* scr, int item, int lane) {
    const int nblk = N / 32, kb = item / nblk, nb = item % nblk, k0 = 64 * kb, n0 = 32 * nb;
#pragma unroll 8
    for (int i = 0; i < 32; ++i) { const int kk = 2 * i + (lane >> 5); scr[kk * 33 + (lane & 31)] = W[(size_t)(k0 + kk) * N + n0 + (lane & 31)]; }
    LDS_WAIT(); asm volatile("" ::: "memory");
    const int c = lane & 7;
#pragma unroll
    for (int j = 0; j < 4; ++j) { const int n = (lane >> 3) + 8 * j; const LAS float* s = scr + (8 * c) * 33 + n;
        u32x4 o; o.x = pk2(s[0 * 33], s[1 * 33]); o.y = pk2(s[2 * 33], s[3 * 33]); o.z = pk2(s[4 * 33], s[5 * 33]); o.w = pk2(s[6 * 33], s[7 * 33]);
        int nn = n0 + n;
        if (QKPERM) { if (nn >= C_Q && nn < C_VA) { const int d = nn & 63; nn = (nn & ~63) + 2 * (d & 31) + (d >> 5); } }
        if (QKPERM) { if (nn >= Z1W) { const int c = nn - Z1W; nn = (c < DM) ? Z1W + (c >> 7) * 256 + (c & 127) : Z1W + ((c - DM) >> 7) * 256 + 128 + (c & 127); } }
        *(u32x4*)(WT + (size_t)nn * ldt + koff + k0 + 8 * c) = o; }
    LDS_WAIT(); asm volatile("" ::: "memory");
}
template <int PART>
__device__ __forceinline__ void p0_prologue(const Ptrs& P, LAS unsigned char* lds, int vcu, int G, int wave, int lane, int tid) {
    LAS float* scr = (LAS float*)(lds + wave * 16384);
    const int gw = vcu * NWAVES + wave, NGW = G * NWAVES;
    const int gt = vcu * NTHR + tid, NGT = G * NTHR;
    constexpr int I_IN = (DM / 64) * (INC / 32), I_PA = (AW / 64) * (DM / 32), I_PB = (BW / 64) * (DM / 32), I_OUT = (DM / 64) * (DM / 32);
    if (PART == 0) {
        bf16_t* WinT = (bf16_t*)(P.ws + WS_WIN);
        for (int it = gw; it < I_IN; it += NGW) p0_transpose_item<true>(P.w_in, INC, WinT, DM, 0, scr, it, lane);
        bf16_t* H = (bf16_t*)(P.ws + WS_H);
        for (int m = gw; m < M; m += NGW) {
            const float* xrow = m < MP ? P.xp + (size_t)m * DM : P.xs + (size_t)(m - MP) * DM;
            const f32x4* xr = (const f32x4*)xrow + lane; f32x4 v[8]; float s = 0.f;
#pragma unroll
            for (int j = 0; j < 8; ++j) { v[j] = xr[64 * j]; s += (v[j][0] * v[j][0] + v[j][1] * v[j][1]) + (v[j][2] * v[j][2] + v[j][3] * v[j][3]); }
            const float rstd = 1.0f / sqrtf(wave_sum(s) * (1.0f / DM) + EPS);
            u32x2* o = (u32x2*)(H + (size_t)m * DM) + lane;
#pragma unroll
            for (int j = 0; j < 8; ++j) { const f32x4 g = ((const f32x4*)P.g_pre)[lane + 64 * j]; const f32x4 y = v[j] * rstd * g; u32x2 w; w.x = pk2(y[0], y[1]); w.y = pk2(y[2], y[3]); o[64 * j] = w; }
        }
        float* rope = (float*)(P.ws + WS_ROPE);
        for (int e = gt; e < NTPOS * 32; e += NGT) {
            const int tp = e >> 5, i = e & 31; const int pos = tp < SEQ ? tp : PAST + (tp - SEQ);
            const double a = (double)pos * kInvFreq[i]; const double k = __builtin_rint(a * 0.15915494309189535); const float r = (float)(a - k * 6.283185307179586);
            *(f32x2*)(rope + (size_t)e * 2) = (f32x2){__cosf(r), __sinf(r)};
        }
        { unsigned* z = (unsigned*)(P.ws + WS_SSQ); for (int e = gt; e < 2 * M + 68 * 64; e += NGT) z[e] = 0u; }
    } else {
        bf16_t* WpT = (bf16_t*)(P.ws + WS_WP); bf16_t* WoutT = (bf16_t*)(P.ws + WS_WOUT);
        for (int it = gw; it < I_PA + I_PB + I_OUT; it += NGW) {
            int r = it;
            if (r < I_PA) { p0_transpose_item<false>(P.w_pa, DM, WpT, 2048, 0, scr, r, lane); continue; } r -= I_PA;
            if (r < I_PB) { p0_transpose_item<false>(P.w_pb, DM, WpT, 2048, 1024, scr, r, lane); continue; } r -= I_PB;
            p0_transpose_item<false>(P.w_out, DM, WoutT, DM, 0, scr, r, lane);
        }
        constexpr int NV = DB * (WIN - DS) * (KVW / 4);
        for (int e = gt; e < 2 * NV; e += NGT) {
            const int which = e >= NV; const int r = which ? e - NV : e; const int db = r / ((WIN - DS) * (KVW / 4)), q = r % ((WIN - DS) * (KVW / 4));
            const f32x4* src = (const f32x4*)(which ? P.cv : P.ck) + (size_t)db * WIN * (KVW / 4) + DS * (KVW / 4) + q;
            f32x4* dst = (f32x4*)(P.out + (which ? O_VWS : O_KWS)) + (size_t)db * WIN * (KVW / 4) + q;
            *dst = *src;
        }
    }
}

constexpr int KS_STRIDE = 72, VT_STRIDE = 264;
constexpr int A_STRIDE = 136;
struct QTileIn { bf16x8 qf0, qf1; u32x2 zw[4]; };
__device__ __forceinline__ QTileIn qtile_load(const bf16_t* qp, const bf16_t* zp, int lane) {
    const int quad = lane >> 4; QTileIn t; t.qf0 = *(const bf16x8*)(qp + quad * 8); t.qf1 = *(const bf16x8*)(qp + 32 + quad * 8);
#pragma unroll
    for (int dt = 0; dt < 4; ++dt) t.zw[dt] = *(const u32x2*)(zp + dt * 16 + quad * 4);
    return t;
}
template <int NKT, int MODE>
__device__ __forceinline__ void attn_qtile(const QTileIn& in, LAS const unsigned char* Ks, LAS const unsigned char* VTs, int lane, int qt, bool first, float sink2, bf16_t* op) {
    const int n = lane & 15, quad = lane >> 4;
    const bf16x8 qf0 = in.qf0, qf1 = in.qf1;
    f32x4 s[NKT];
    const int qi = (MODE == 0) ? qt * 16 + n : (n & 7);
#pragma unroll
    for (int kt = 0; kt < NKT; ++kt) {
        bool need;
        if (MODE == 0) need = (kt < 8) ? (!first && kt >= qt) : (kt - 8 <= qt); else need = kt < 9;
        s[kt] = (f32x4){-1e30f, -1e30f, -1e30f, -1e30f};
        if (need) {
            const LAS unsigned char* kp = Ks + (kt * 16 + n) * (KS_STRIDE * 2) + quad * 16;
            const bf16x8 k0 = *(const LAS bf16x8*)kp, k1 = *(const LAS bf16x8*)(kp + 64);
            f32x4 c = {0.f, 0.f, 0.f, 0.f};
            c = __builtin_amdgcn_mfma_f32_16x16x32_bf16(k0, qf0, c, 0, 0, 0);
            c = __builtin_amdgcn_mfma_f32_16x16x32_bf16(k1, qf1, c, 0, 0, 0);
#pragma unroll
            for (int j = 0; j < 4; ++j) { const int kk = kt * 16 + quad * 4 + j; bool vis;
                if (MODE == 0) vis = (kk < 128) ? (kk > qi) : (kk - 128 <= qi); else vis = (kk < 128) ? (kk > qi) : (kk - 128 <= qi);
                s[kt][j] = vis ? c[j] : -1e30f; }
        }
    }
    float mx = -1e30f;
#pragma unroll
    for (int kt = 0; kt < NKT; ++kt) mx = fmaxf(mx, fmaxf(fmaxf(s[kt][0], s[kt][1]), fmaxf(s[kt][2], s[kt][3])));
    mx = fmaxf(mx, __shfl_xor(mx, 16)); mx = fmaxf(mx, __shfl_xor(mx, 32)); mx = fmaxf(mx, sink2);
    float sum = 0.f;
#pragma unroll
    for (int kt = 0; kt < NKT; ++kt) {
#pragma unroll
        for (int j = 0; j < 4; ++j) { const float p = __builtin_amdgcn_exp2f(s[kt][j] - mx); s[kt][j] = p; sum += p; } }
    sum += __shfl_xor(sum, 16); sum += __shfl_xor(sum, 32); sum += __builtin_amdgcn_exp2f(sink2 - mx);
    const float inv = 1.0f / sum;
    f32x4 o[4];
#pragma unroll
    for (int dt = 0; dt < 4; ++dt) o[dt] = (f32x4){0.f, 0.f, 0.f, 0.f};
#pragma unroll
    for (int pp = 0; pp < NKT / 2; ++pp) {
        bool need;
        if (MODE == 0) need = (pp < 4) ? (!first && 2 * pp + 1 >= qt) : (2 * pp - 8 <= qt); else need = pp < 5;
        if (need) {
            u32x4 pw; pw.x = pk2(s[2 * pp][0], s[2 * pp][1]); pw.y = pk2(s[2 * pp][2], s[2 * pp][3]); pw.z = pk2(s[2 * pp + 1][0], s[2 * pp + 1][1]); pw.w = pk2(s[2 * pp + 1][2], s[2 * pp + 1][3]);
            const bf16x8 pf = __builtin_bit_cast(bf16x8, pw);
#pragma unroll
            for (int dt = 0; dt < 4; ++dt) {
                const LAS unsigned char* vp = VTs + (dt * 16 + n) * (VT_STRIDE * 2) + (pp * 32 + quad * 4) * 2;
                const u32x2 v0 = *(const LAS u32x2*)vp, v1 = *(const LAS u32x2*)(vp + 32);
                const u32x4 vw = {v0.x, v0.y, v1.x, v1.y};
                o[dt] = __builtin_amdgcn_mfma_f32_16x16x32_bf16(__builtin_bit_cast(bf16x8, vw), pf, o[dt], 0, 0, 0);
            }
        }
    }
#pragma unroll
    for (int dt = 0; dt < 4; ++dt) {
        const u32x2 zw = in.zw[dt];
        const f32x4 z = {pg8::bf_lo(zw.x), pg8::bf_hi(zw.x), pg8::bf_lo(zw.y), pg8::bf_hi(zw.y)};
        const f32x4 r = o[dt] * inv * z; u32x2 w; w.x = pk2(r[0], r[1]); w.y = pk2(r[2], r[3]);
        *(u32x2*)(op + dt * 16 + quad * 4) = w;
    }
}

struct QTile2In { bf16x8 qf[2][2]; u32x2 zw[2][4]; };
__device__ __forceinline__ void attn_qtile2(const QTile2In& in, LAS const unsigned char* Ks, LAS const unsigned char* VTs, int lane, int qt0, bool first, float sink2, bf16_t* op0) {
    const int n = lane & 15, quad = lane >> 4;
    f32x4 s[2][9];
#pragma unroll
    for (int T = 0; T < 2; ++T) {
        const int qt = qt0 + T; const int qi = qt * 16 + n;
        const LAS unsigned char* kb = Ks + (qt * 16 + n) * (KS_STRIDE * 2) + quad * 16;
#pragma unroll
        for (int r = 0; r < 9; ++r) {
            const LAS unsigned char* kp = kb + r * 16 * (KS_STRIDE * 2);
            const bf16x8 k0 = *(const LAS bf16x8*)kp, k1 = *(const LAS bf16x8*)(kp + 64);
            f32x4 c = {0.f, 0.f, 0.f, 0.f};
            c = __builtin_amdgcn_mfma_f32_16x16x32_bf16(k0, in.qf[T][0], c, 0, 0, 0);
            c = __builtin_amdgcn_mfma_f32_16x16x32_bf16(k1, in.qf[T][1], c, 0, 0, 0);
#pragma unroll
            for (int j = 0; j < 4; ++j) { const int kk = (qt + r) * 16 + quad * 4 + j; const bool vis = (kk < 128) ? (!first && kk > qi) : (kk - 128 <= qi);
                s[T][r][j] = vis ? c[j] : -1e30f; }
        }
    }
    float inv[2];
#pragma unroll
    for (int T = 0; T < 2; ++T) {
        float mx = -1e30f;
#pragma unroll
        for (int r = 0; r < 9; ++r) mx = fmaxf(mx, fmaxf(fmaxf(s[T][r][0], s[T][r][1]), fmaxf(s[T][r][2], s[T][r][3])));
        mx = fmaxf(mx, __shfl_xor(mx, 16)); mx = fmaxf(mx, __shfl_xor(mx, 32)); mx = fmaxf(mx, sink2);
        float sum = 0.f;
#pragma unroll
        for (int r = 0; r < 9; ++r) {
#pragma unroll
            for (int j = 0; j < 4; ++j) { const float p = __builtin_amdgcn_exp2f(s[T][r][j] - mx); s[T][r][j] = p; sum += p; } }
        sum += __shfl_xor(sum, 16); sum += __shfl_xor(sum, 32); sum += __builtin_amdgcn_exp2f(sink2 - mx);
        inv[T] = 1.0f / sum;
    }
#pragma unroll
    for (int T = 0; T < 2; ++T) {
        const int qt = qt0 + T;
        f32x4 o[4];
#pragma unroll
        for (int dt = 0; dt < 4; ++dt) o[dt] = (f32x4){0.f, 0.f, 0.f, 0.f};
#pragma unroll
        for (int pp = 0; pp < 5; ++pp) {
            u32x4 pw; pw.x = pk2(s[T][2 * pp][0], s[T][2 * pp][1]); pw.y = pk2(s[T][2 * pp][2], s[T][2 * pp][3]);
            if (pp < 4) { pw.z = pk2(s[T][2 * pp + 1][0], s[T][2 * pp + 1][1]); pw.w = pk2(s[T][2 * pp + 1][2], s[T][2 * pp + 1][3]); } else { pw.z = 0u; pw.w = 0u; }
            const bf16x8 pf = __builtin_bit_cast(bf16x8, pw);
#pragma unroll
            for (int dt = 0; dt < 4; ++dt) {
                const LAS unsigned char* vp = VTs + (dt * 16 + n) * (VT_STRIDE * 2) + ((qt + 2 * pp) * 16 + quad * 4) * 2;
                const u32x2 v0 = *(const LAS u32x2*)vp, v1 = *(const LAS u32x2*)(vp + (pp < 4 ? 32 : 0));
                const u32x4 vw = {v0.x, v0.y, v1.x, v1.y};
                o[dt] = __builtin_amdgcn_mfma_f32_16x16x32_bf16(__builtin_bit_cast(bf16x8, vw), pf, o[dt], 0, 0, 0);
            }
        }
        bf16_t* op = op0 + (size_t)T * 16 * 2048;
#pragma unroll
        for (int dt = 0; dt < 4; ++dt) {
            const u32x2 zw = in.zw[T][dt];
            const f32x4 z = {pg8::bf_lo(zw.x), pg8::bf_hi(zw.x), pg8::bf_lo(zw.y), pg8::bf_hi(zw.y)};
            const f32x4 rr = o[dt] * inv[T] * z; u32x2 w; w.x = pk2(rr[0], rr[1]); w.y = pk2(rr[2], rr[3]);
            *(u32x2*)(op + dt * 16 + quad * 4) = w;
        }
    }
}
__device__ __forceinline__ void p2_mixers(const Ptrs& P, LAS unsigned char* lds, int vcu, int G, int wave, int lane, int tid) {
    bf16_t* Z1 = (bf16_t*)(P.ws + WS_Z1); bf16_t* AB = (bf16_t*)(P.ws + WS_H); const float* stats = (const float*)(P.ws + WS_STATS);
    {
        LAS unsigned char* vnT = lds; LAS unsigned char* Wl = lds + 128 * A_STRIDE * 2; LAS float* mr = (LAS float*)(lds + 2 * 128 * A_STRIDE * 2);
        const int g = vcu & 7;
#pragma unroll
        for (int i = 0; i < 8; ++i) { const int e = tid + i * NTHR, t = e >> 5, s0 = (e & 31) * 4;
            const f32x4 w = *(const f32x4*)(P.w_sp + ((size_t)g * CH + t) * CH + s0);
            u32x2 o; o.x = pk2(s0 <= t ? w[0] : 0.f, s0 + 1 <= t ? w[1] : 0.f); o.y = pk2(s0 + 2 <= t ? w[2] : 0.f, s0 + 3 <= t ? w[3] : 0.f);
            *(LAS u32x2*)(Wl + t * (A_STRIDE * 2) + s0 * 2) = o; }
        const f32x4 lg0 = *(const f32x4*)(P.ln_g + g * CH + (tid & 15) * 8), lg1 = *(const f32x4*)(P.ln_g + g * CH + (tid & 15) * 8 + 4);
        const f32x4 lb0 = *(const f32x4*)(P.ln_b + g * CH + (tid & 15) * 8), lb1 = *(const f32x4*)(P.ln_b + g * CH + (tid & 15) * 8 + 4);
        u32x4 gvr[4]; f32x4 st0, st1;
#define A_PREFETCH(UN) do { const int row0_ = ((UN) >> 3) * CH; \
            _Pragma("unroll") for (int i = 0; i < 4; ++i) { const int e = tid + i * NTHR; gvr[i] = *(const u32x4*)(Z1 + (size_t)(row0_ + (e >> 4)) * Z1W + C_V + g * CH + (e & 15) * 8); } \
            const f32x4* sp_ = (const f32x4*)(stats + (size_t)(row0_ + (tid >> 2)) * 32) + (tid & 3) * 2; st0 = sp_[0]; st1 = sp_[1]; } while (0)
        int un = vcu;
        if (un < (MP / CH) * NG) A_PREFETCH(un);
        for (; un < (MP / CH) * NG; un += G) {
            const int row0 = (un >> 3) * CH;
            u32x2 uw[8], zw[8];
            { const size_t zr_ = (size_t)(row0 + wave * 16 + (lane & 15)) * Z1W + g * CH + (lane >> 4) * 4;
#pragma unroll
              for (int ct = 0; ct < 8; ++ct) { uw[ct] = *(const u32x2*)(Z1 + zr_ + C_U + ct * 16); zw[ct] = *(const u32x2*)(Z1 + zr_ + C_ZA + ct * 16); } }
            { float sm = (st0[0] + st0[2]) + (st1[0] + st1[2]), q = (st0[1] + st0[3]) + (st1[1] + st1[3]);
              sm += __shfl_xor(sm, 1); q += __shfl_xor(q, 1); sm += __shfl_xor(sm, 2); q += __shfl_xor(q, 2);
              const float mean = sm * (1.0f / AW), var = q * (1.0f / AW) - mean * mean;
              if ((tid & 3) == 0) { mr[(tid >> 2) * 2] = mean; mr[(tid >> 2) * 2 + 1] = 1.0f / sqrtf(fmaxf(var, 0.f) + EPS); } }
            __syncthreads();
#pragma unroll
            for (int i = 0; i < 4; ++i) { const int e = tid + i * NTHR, sr = e >> 4, c0 = (e & 15) * 8;
                f32x4 a, b; unpack8(gvr[i], a, b);
                const float mean = mr[sr * 2], rstd = mr[sr * 2 + 1];
                a = (a - mean) * rstd * lg0 + lb0; b = (b - mean) * rstd * lg1 + lb1;
                const u32x4 pw = pg8::pack8(a, b); const int rot = (e & 15);
#pragma unroll
                for (int j = 0; j < 8; ++j) { const int idx = (j + rot) & 7; *(LAS bf16_t*)(vnT + (c0 + idx) * (A_STRIDE * 2) + sr * 2) = pick16(pw, idx); } }
            if (un + G < (MP / CH) * NG) A_PREFETCH(un + G);
            __syncthreads();
            {
                const int n = lane & 15, quad = lane >> 4, t = wave * 16 + n; const int nks = (wave >> 1) + 1;
                const int row = row0 + t; const float bs = P.b_sp[g * CH + t];
                f32x4 acc[8];
#pragma unroll
                for (int ct = 0; ct < 8; ++ct) acc[ct] = (f32x4){0.f, 0.f, 0.f, 0.f};
#pragma unroll 1
                for (int ks = 0; ks < nks; ++ks) {
                    const bf16x8 wf = *(const LAS bf16x8*)(Wl + t * (A_STRIDE * 2) + (ks * 32 + quad * 8) * 2);
#pragma unroll
                    for (int ct = 0; ct < 8; ++ct) { const int c = ct * 16 + n; const bf16x8 vf = *(const LAS bf16x8*)(vnT + c * (A_STRIDE * 2) + (ks * 32 + quad * 8) * 2);
                        acc[ct] = __builtin_amdgcn_mfma_f32_16x16x32_bf16(vf, wf, acc[ct], 0, 0, 0); }
                }
#pragma unroll
                for (int ct = 0; ct < 8; ++ct) { const int col = g * CH + ct * 16 + quad * 4;
                    const f32x4 uu = {pg8::bf_lo(uw[ct].x), pg8::bf_hi(uw[ct].x), pg8::bf_lo(uw[ct].y), pg8::bf_hi(uw[ct].y)}, zz = {pg8::bf_lo(zw[ct].x), pg8::bf_hi(zw[ct].x), pg8::bf_lo(zw[ct].y), pg8::bf_hi(zw[ct].y)};
                    const f32x4 r = uu * (acc[ct] + bs) * zz; u32x2 w; w.x = pk2(r[0], r[1]); w.y = pk2(r[2], r[3]);
                    *(u32x2*)(AB + (size_t)row * 2048 + col) = w; }
            }
            __syncthreads();
        }
#undef A_PREFETCH
    }
    {
        LAS float* mr = (LAS float*)lds;
        for (int db = vcu; db < DB; db += G) {
            const int row0 = MP + db * DS;
            if (tid < DS) {
                const f32x4* sp = (const f32x4*)(stats + (size_t)(row0 + tid) * 32); float s = 0.f, q = 0.f;
#pragma unroll
                for (int j = 0; j < 8; ++j) { const f32x4 v = sp[j]; s += v[0] + v[2]; q += v[1] + v[3]; }
                const float mean = s * (1.0f / AW), var = q * (1.0f / AW) - mean * mean;
                mr[tid * 2] = mean; mr[tid * 2 + 1] = 1.0f / sqrtf(fmaxf(var, 0.f) + EPS);
            }
            __syncthreads();
            const int c = tid * 2, g = c >> 7;
            const f32x2 lg = *(const f32x2*)(P.ln_g + c), lb = *(const f32x2*)(P.ln_b + c);
            f32x2 vn[DS];
#pragma unroll
            for (int s = 0; s < DS; ++s) { const unsigned w = *(const unsigned*)(Z1 + (size_t)(row0 + s) * Z1W + C_V + c);
                const float mean = mr[s * 2], rstd = mr[s * 2 + 1];
                vn[s] = (f32x2){(pg8::bf_lo(w) - mean) * rstd * lg.x + lb.x, (pg8::bf_hi(w) - mean) * rstd * lg.y + lb.y};
                *(f32x2*)(P.out + O_CV + (size_t)(db * DS + s) * AW + c) = vn[s]; }
#pragma unroll
            for (int t = 0; t < DS; ++t) {
                const float bs = P.b_sp[g * CH + t]; f32x2 acc = {bs, bs};
#pragma unroll
                for (int s = 0; s <= t; ++s) { const float w = P.w_sp[((size_t)g * CH + t) * CH + s]; acc += vn[s] * w; }
                const unsigned uw = *(const unsigned*)(Z1 + (size_t)(row0 + t) * Z1W + C_U + c), zw = *(const unsigned*)(Z1 + (size_t)(row0 + t) * Z1W + C_ZA + c);
                *(unsigned*)(AB + (size_t)(row0 + t) * 2048 + c) = pk2(pg8::bf_lo(uw) * acc.x * pg8::bf_lo(zw), pg8::bf_hi(uw) * acc.y * pg8::bf_hi(zw));
            }
            __syncthreads();
        }
    }
    LAS unsigned char* Ks = lds; LAS unsigned char* VTs = lds + 256 * KS_STRIDE * 2;
    {
        u32x4 kr[4], vr[4];
#define B_PREFETCH(UN) do { const int blk_ = (UN) & 15, kvh_ = ((UN) >> 4) & 3, b_ = (UN) >> 6; const int krow0_ = b_ * SEQ + (blk_ - 1) * WIN; \
            _Pragma("unroll") for (int i = 0; i < 4; ++i) { const int e = tid + i * NTHR, key = e >> 3, c8 = (e & 7) * 8; \
                if (!(blk_ == 0 && key < WIN)) { const size_t zr = (size_t)(krow0_ + key) * Z1W; kr[i] = *(const u32x4*)(Z1 + zr + C_K + kvh_ * HD + c8); vr[i] = *(const u32x4*)(Z1 + zr + C_VA + kvh_ * HD + c8); } } } while (0)
        int un = vcu;
        if (un < NB * NKV * (SEQ / WIN)) B_PREFETCH(un);
        for (; un < NB * NKV * (SEQ / WIN); un += G) {
            const int blk = un & 15, kvh = (un >> 4) & 3, b = un >> 6; const bool first = blk == 0;
#pragma unroll
            for (int i = 0; i < 4; ++i) { const int e = tid + i * NTHR, key = e >> 3, c8 = (e & 7) * 8;
                const bool dead = first && key < WIN;
                const u32x4 kw = dead ? (u32x4){0u, 0u, 0u, 0u} : kr[i]; const u32x4 vw = dead ? (u32x4){0u, 0u, 0u, 0u} : vr[i];
                *(LAS u32x4*)(Ks + key * (KS_STRIDE * 2) + c8 * 2) = kw;
#pragma unroll
                for (int j = 0; j < 8; ++j) { const int idx = (j + (e & 7)) & 7; *(LAS bf16_t*)(VTs + (c8 + idx) * (VT_STRIDE * 2) + key * 2) = pick16(vw, idx); }
            }
            if (un + G < NB * NKV * (SEQ / WIN)) B_PREFETCH(un + G);
            __syncthreads();
            {
                const int head = kvh * 4 + (wave >> 1); const float sink2 = P.sinks[head] * LOG2E;
                const int rowb = b * SEQ + blk * WIN + (wave & 1) * 64 + (lane & 15);
                const bf16_t* qb = Z1 + (size_t)rowb * Z1W + C_Q + head * HD; const bf16_t* zb = Z1 + (size_t)rowb * Z1W + C_ZB + head * HD;
                const int quad_ = lane >> 4;
                QTile2In cur;
#pragma unroll
                for (int T = 0; T < 2; ++T) { const bf16_t* qn = qb + (size_t)T * 16 * Z1W; cur.qf[T][0] = *(const bf16x8*)(qn + quad_ * 8); cur.qf[T][1] = *(const bf16x8*)(qn + 32 + quad_ * 8); }
#pragma unroll 1
                for (int h2 = 0; h2 < 2; ++h2) {
#pragma unroll
                    for (int T = 0; T < 2; ++T)
#pragma unroll
                        for (int dt = 0; dt < 4; ++dt) cur.zw[T][dt] = *(const u32x2*)(zb + (size_t)(h2 * 2 + T) * 16 * Z1W + dt * 16 + quad_ * 4);
                    QTile2In use = cur;
                    if (h2 == 0) {
#pragma unroll
                        for (int T = 0; T < 2; ++T) { const bf16_t* qn = qb + (size_t)(2 + T) * 16 * Z1W; cur.qf[T][0] = *(const bf16x8*)(qn + quad_ * 8); cur.qf[T][1] = *(const bf16x8*)(qn + 32 + quad_ * 8); } }
                    attn_qtile2(use, Ks, VTs, lane, (wave & 1) * 4 + h2 * 2, first, sink2, AB + (size_t)(rowb + h2 * 32) * 2048 + AW + head * HD);
                }
            }
            __syncthreads();
        }
#undef B_PREFETCH
    }
    f32x4 ckr[4], cvr[4];
#define S_PREFETCH(UN) do { const int kvh_ = (UN) & 3, db_ = (UN) >> 2; \
        _Pragma("unroll") for (int i = 0; i < 4; ++i) { const int e = tid + i * NTHR; const size_t src = ((size_t)(db_ * WIN + (e >> 4)) * NKV + kvh_) * HD + (e & 15) * 4; \
            ckr[i] = *(const f32x4*)(P.ck + src); cvr[i] = *(const f32x4*)(P.cv + src); } } while (0)
    if (vcu < DB * NKV) S_PREFETCH(vcu);
    for (int un = vcu; un < DB * NKV; un += G) {
        const int kvh = un & 3, db = un >> 2; const int row0 = MP + db * DS;
        QTileIn qin;
        const int n_ = lane & 15; const int head_ = kvh * 4 + (wave & 1) * 2 + (n_ >> 3); const int row_ = row0 + (n_ & 7);
        if (wave < 2) qin = qtile_load(Z1 + (size_t)row_ * Z1W + C_Q + head_ * HD, Z1 + (size_t)row_ * Z1W + C_ZB + head_ * HD, lane);
#pragma unroll
        for (int i = 0; i < 4; ++i) { const int e = tid + i * NTHR, key = e >> 4, d0 = (e & 15) * 4;
            const f32x4 kv = ckr[i]; const f32x4 vv = cvr[i];
            const int i0 = d0 & 31, eo = d0 >> 5;
#pragma unroll
            for (int j = 0; j < 4; ++j) { *(LAS bf16_t*)(Ks + key * (KS_STRIDE * 2) + (2 * (i0 + j) + eo) * 2) = (bf16_t)f2bf(kv[j]);
                                          *(LAS bf16_t*)(VTs + (d0 + j) * (VT_STRIDE * 2) + key * 2) = (bf16_t)f2bf(vv[j]); } }
        if (un + G < DB * NKV) S_PREFETCH(un + G);
        if (tid < 32 * 8) { const int key = 128 + (tid >> 3), c8 = (tid & 7) * 8; u32x4 kw = {0u, 0u, 0u, 0u}, vw = {0u, 0u, 0u, 0u};
            if (key < 128 + DS) { const size_t zr = (size_t)(row0 + key - 128) * Z1W; kw = *(const u32x4*)(Z1 + zr + C_K + kvh * HD + c8); vw = *(const u32x4*)(Z1 + zr + C_VA + kvh * HD + c8); }
            *(LAS u32x4*)(Ks + key * (KS_STRIDE * 2) + c8 * 2) = kw;
            LAS unsigned char* vt = VTs + c8 * (VT_STRIDE * 2) + key * 2;
            *(LAS bf16_t*)(vt + 0 * VT_STRIDE * 2) = (bf16_t)(vw.x & 0xffff); *(LAS bf16_t*)(vt + 1 * VT_STRIDE * 2) = (bf16_t)(vw.x >> 16);
            *(LAS bf16_t*)(vt + 2 * VT_STRIDE * 2) = (bf16_t)(vw.y & 0xffff); *(LAS bf16_t*)(vt + 3 * VT_STRIDE * 2) = (bf16_t)(vw.y >> 16);
            *(LAS bf16_t*)(vt + 4 * VT_STRIDE * 2) = (bf16_t)(vw.z & 0xffff); *(LAS bf16_t*)(vt + 5 * VT_STRIDE * 2) = (bf16_t)(vw.z >> 16);
            *(LAS bf16_t*)(vt + 6 * VT_STRIDE * 2) = (bf16_t)(vw.w & 0xffff); *(LAS bf16_t*)(vt + 7 * VT_STRIDE * 2) = (bf16_t)(vw.w >> 16);
        }
        __syncthreads();
        if (wave < 2) attn_qtile<10, 1>(qin, Ks, VTs, lane, 0, false, P.sinks[head_] * LOG2E, AB + (size_t)row_ * 2048 + AW + head_ * HD);
        __syncthreads();
    }
#undef S_PREFETCH
}

__device__ __forceinline__ void stagger_wait(int ticks) {
    if (ticks > 0) { const unsigned long long t0 = __builtin_amdgcn_s_memrealtime(); while ((long long)(__builtin_amdgcn_s_memrealtime() - t0) < (long long)ticks) __builtin_amdgcn_s_sleep(16); }
}
#ifndef STAG1
#define STAG1 500
#endif
#ifndef STAG3
#define STAG3 600
#endif
struct Args { Ptrs p; int ph_lo, ph_hi; };
typedef const __attribute__((address_space(4))) Args* KArgPtr;
__device__ __forceinline__ Ptrs load_ptrs() {
    KArgPtr ap = (KArgPtr)__builtin_amdgcn_kernarg_segment_ptr(); asm volatile("" : "+s"(ap));
    Ptrs P; P.xp = ap->p.xp; P.xs = ap->p.xs; P.ck = ap->p.ck; P.cv = ap->p.cv; P.g_pre = ap->p.g_pre; P.w_in = ap->p.w_in; P.ln_g = ap->p.ln_g; P.ln_b = ap->p.ln_b;
    P.w_sp = ap->p.w_sp; P.b_sp = ap->p.b_sp; P.sinks = ap->p.sinks; P.w_pa = ap->p.w_pa; P.w_pb = ap->p.w_pb; P.w_out = ap->p.w_out; P.g_post = ap->p.g_post; P.out = ap->p.out; P.ws = ap->p.ws;
    return P;
}
__global__ void __launch_bounds__(NTHR, 2) fwd_kernel(Args args) {
    extern __shared__ __attribute__((aligned(16))) unsigned char lds_raw[];
    LAS unsigned char* lds = (LAS unsigned char*)lds_raw;
    const int tid = threadIdx.x, lane = tid & 63, wave = __builtin_amdgcn_readfirstlane(tid >> 6);
    const int G = gridDim.x, bx = blockIdx.x; int vcu = (G % 8 == 0) ? (bx % 8) * (G / 8) + bx / 8 : bx;
    const int lo = args.ph_lo, hi = args.ph_hi;
#ifndef PH_MASK
#define PH_MASK 63
#endif
#define IN(k) (((PH_MASK >> (k)) & 1) && lo <= (k) && (k) < hi)
#ifndef DUP_MASK
#define DUP_MASK 0
#endif
#define REP(k) for (int rep_ = 0; rep_ < (((DUP_MASK >> (k)) & 1) ? 2 : 1); ++rep_)
#define SEAM(k) do { if (IN(k) && IN((k) + 1)) xcd_barrier(bar); } while (0)
    if (lo == -12345) cg::this_grid().sync();
    volatile LAS unsigned* st = (volatile LAS unsigned*)(lds + 131072 + 64);
    if (tid < 3) st[tid] = 0u;
    __syncthreads();
    XcdBarrier bar; bar.bar = nullptr; bar.x = 0; bar.st = nullptr;
    if (hi - lo > 1) { KArgPtr ap0 = (KArgPtr)__builtin_amdgcn_kernarg_segment_ptr(); bar = xcd_barrier_post((unsigned*)(ap0->p.ws + WS_CTL), st); }
    __syncthreads();
    if (hi - lo > 1 && G == 256) { const unsigned rk = st[2]; if (bar.x < 8u && rk < 32u) vcu = (int)(bar.x * 32u + rk); }
    vcu = __builtin_amdgcn_readfirstlane(vcu);
    if (IN(0)) REP(0) { const Ptrs P = load_ptrs(); p0_prologue<0>(P, lds, vcu, G, wave, lane, tid); __syncthreads(); }
    SEAM(0);
    if (IN(1)) REP(1) {
        const Ptrs P = load_ptrs();
        bf16_t* WinT = (bf16_t*)(P.ws + WS_WIN); bf16_t* H = (bf16_t*)(P.ws + WS_H);
        pg8::StaticOrder S; S.init(M, INC, G, bx, 1); S.A0 = H; S.A1 = H; S.Bt0 = WinT; S.Bt1 = WinT; S.ntile = DM / 64;
        EpiIn E{(bf16_t*)(P.ws + WS_Z1), (bf16_t*)(P.ws + WS_G), (float*)(P.ws + WS_STATS), (const float*)(P.ws + WS_ROPE), P.out};
        pg8::gemm_phase<EpiIn, pg8::StaticOrder, true, true>(lds, S, E);
        { constexpr int NBIG = (M / 256) * (INC / 256) - 10 * 256;
          if (G == 256 && bx >= NBIG) p0_prologue<1>(P, lds, bx - NBIG, G - NBIG, wave, lane, tid); else if (G != 256) p0_prologue<1>(P, lds, vcu, G, wave, lane, tid); }
    }
    SEAM(1);
    if (IN(2)) REP(2) { const Ptrs P = load_ptrs(); p2_mixers(P, lds, vcu, G, wave, lane, tid); }
    SEAM(2);
    if (IN(3)) {
        const Ptrs P = load_ptrs();
        unsigned* ctr = (unsigned*)(P.ws + WS_SSQ);
        MOOrder S; S.c = vcu; S.AB = (const bf16_t*)(P.ws + WS_H); S.WpT = (const bf16_t*)(P.ws + WS_WP); S.MG = (const bf16_t*)(P.ws + WS_Z1); S.WoutT = (const bf16_t*)(P.ws + WS_WOUT); S.mgcnt = ctr + 2 * M;
        EpiMO E{EpiMerge{(const bf16_t*)(P.ws + WS_G), (bf16_t*)(P.ws + WS_Z1), ctr + 2 * M}, EpiOutNorm{P.xp, P.xs, P.g_post, P.out + O_Y, ctr}};
        pg8::gemm_phase<EpiMO, MOOrder, true, true>(lds, S, E);
    }
#undef IN
#undef SEAM
}

extern "C" void kernel_launch(void* const* d_in, const int* in_sizes, int n_in, void* d_out, int out_size, void* d_ws, size_t ws_size, hipStream_t stream) {
    static int grid = 0;
    if (grid == 0) {
        if (n_in != 15 || in_sizes[0] != MP * DM || (size_t)out_size != O_END || ws_size < WS_END) {
            fprintf(stderr, "kernel_launch: unexpected shapes (n_in %d, in0 %d, out %d, ws %zu, need %zu)\n", n_in, n_in > 0 ? in_sizes[0] : -1, out_size, ws_size, (size_t)WS_END); grid = -1; return; }
        if (hipFuncSetAttribute((const void*)fwd_kernel, hipFuncAttributeMaxDynamicSharedMemorySize, LDS_BYTES) != hipSuccess) { fprintf(stderr, "kernel_launch: hipFuncSetAttribute failed\n"); grid = -1; return; }
        int dev = 0, cus = 0, per_cu = 0;
        hipGetDevice(&dev); hipDeviceGetAttribute(&cus, hipDeviceAttributeMultiprocessorCount, dev);
        hipOccupancyMaxActiveBlocksPerMultiprocessor(&per_cu, (const void*)fwd_kernel, NTHR, LDS_BYTES);
        if (per_cu < 1) { fprintf(stderr, "kernel_launch: occupancy query says %d blocks per CU\n", per_cu); per_cu = 1; }
        (void)hipGetLastError();
        grid = cus;
    }
    if (grid < 0) return;
    if (hipMemsetAsync((char*)d_ws + WS_CTL, 0, CTL_ZERO_BYTES, stream) != hipSuccess) { fprintf(stderr, "kernel_launch: hipMemsetAsync failed\n"); return; }
    Args a{};
    a.p.xp = (const float*)d_in[0]; a.p.xs = (const float*)d_in[1]; a.p.ck = (const float*)d_in[2]; a.p.cv = (const float*)d_in[3]; a.p.g_pre = (const float*)d_in[4];
    a.p.w_in = (const float*)d_in[5]; a.p.ln_g = (const float*)d_in[6]; a.p.ln_b = (const float*)d_in[7]; a.p.w_sp = (const float*)d_in[8]; a.p.b_sp = (const float*)d_in[9];
    a.p.sinks = (const float*)d_in[10]; a.p.w_pa = (const float*)d_in[11]; a.p.w_pb = (const float*)d_in[12]; a.p.w_out = (const float*)d_in[13]; a.p.g_post = (const float*)d_in[14];
    a.p.out = (float*)d_out; a.p.ws = (unsigned char*)d_ws;
#if MK_N_LAUNCHES == 1
    a.ph_lo = 0; a.ph_hi = 4;
    void* kargs[] = {&a};
    hipError_t e = hipLaunchCooperativeKernel((const void*)fwd_kernel, dim3(grid), dim3(NTHR), kargs, LDS_BYTES, stream);
    if (e != hipSuccess) fprintf(stderr, "kernel_launch: cooperative launch failed: %s (grid %d)\n", hipGetErrorString(e), grid);
#else
    for (int ph = 0; ph < 4; ++ph) { a.ph_lo = ph; a.ph_hi = ph + 1; hipLaunchKernelGGL(fwd_kernel, dim3(grid), dim3(NTHR), LDS_BYTES, stream, a); }
#endif
}
```

```cpp
#include <hip/hip_runtime.h>
#include <hip/hip_cooperative_groups.h>
#include <cstdio>
#include <cstdint>
namespace cg = cooperative_groups;

#ifndef MK_N_LAUNCHES
#define MK_N_LAUNCHES 1
#endif

namespace pg8 {
#define PG8_LAS __attribute__((address_space(3)))
typedef unsigned short bf16_t;
typedef short bf16x8 __attribute__((ext_vector_type(8)));
typedef float f32x4 __attribute__((ext_vector_type(4)));
typedef float f32x2 __attribute__((ext_vector_type(2)));
typedef unsigned u32x4 __attribute__((ext_vector_type(4)));
typedef unsigned u32x2 __attribute__((ext_vector_type(2)));
constexpr int BM = 256, BK = 64, HALF = 128, HTB = HALF * BK * 2  , STAGE_BYTES = 8 * HTB, NXCD = 8, WGM = 8;

__host__ __device__ __forceinline__ int lds_byte(int r, int c) { const int st = (r >> 4) * 2 + (c >> 5), rr = r & 15, cc = c & 31, ob = rr * 64 + cc * 2; return st * 1024 + (ob ^ (((ob >> 9) & 1) << 5)); }
__host__ __device__ __forceinline__ void stage_rc(int b, int& R, int& C) { const int st = b / 1024, sb = b % 1024, swz = sb ^ (((sb >> 9) & 1) << 5); R = (st >> 1) * 16 + swz / 64; C = (st & 1) * 32 + (swz % 64) / 2; }
__host__ __device__ __forceinline__ int perm32(int rho) { const int n = rho >> 4, i = rho & 15; return 8 * (i >> 2) + 4 * n + (i & 3); }

struct Unit { int pm, pn, kh, ty; };
constexpr size_t TSTEP = (size_t)256 * 2048 * 2;

struct StaticOrder {
    int nM, nN, nwg, G, c, nkh; const bf16_t *A0, *A1, *Bt0, *Bt1; int ntile;
    __device__ void init(int M, int N, int G_, int c_, int nkh_) { nM = M / BM; nN = N / BM; nwg = nM * nN; G = G_; c = c_; nkh = nkh_; }
    __device__ bool next(int i, Unit& u) const {
        const int ti = (nkh == 2) ? (i >> 1) : i; u.kh = (nkh == 2) ? (i & 1) : 0; u.ty = 0;
        const long L = (long)ti * G + c; if (L >= nwg) return false;
        int wgid = (int)L; { const int q = nwg / NXCD, r = nwg % NXCD, xcd = wgid % NXCD, off = wgid / NXCD; wgid = (xcd < r ? xcd * (q + 1) : r * (q + 1) + (xcd - r) * q) + off; }
        const int nig = WGM * nN, gid = wgid / nig, fm = gid * WGM, gsz = (nM - fm) < WGM ? (nM - fm) : WGM;
        u.pm = fm + ((wgid % nig) % gsz); u.pn = (wgid % nig) / gsz; return true;
    }
    __device__ __forceinline__ void operands(const Unit& u, const char*& A, const char*& B, int& nt) const {
        A = (const char*)(u.kh ? A1 : A0) + (size_t)u.pm * TSTEP; B = (const char*)(u.kh ? Bt1 : Bt0) + (size_t)u.pn * TSTEP; nt = ntile; }
    __device__ __forceinline__ void a_ready(const Unit&) const {}
    __device__ __forceinline__ void done(const Unit&) const {}
};

__device__ __forceinline__ unsigned cvt_pk_bf16(float lo, float hi) { unsigned r; asm volatile("v_cvt_pk_bf16_f32 %0, %1, %2" : "=v"(r) : "v"(lo), "v"(hi)); return r; }
__device__ __forceinline__ u32x4 pack8(f32x4 a, f32x4 b) { u32x4 w; w.x = cvt_pk_bf16(a[0], a[1]); w.y = cvt_pk_bf16(a[2], a[3]); w.z = cvt_pk_bf16(b[0], b[1]); w.w = cvt_pk_bf16(b[2], b[3]); return w; }
__device__ __forceinline__ float bf_lo(unsigned w) { return __uint_as_float(w << 16); }
__device__ __forceinline__ float bf_hi(unsigned w) { return __uint_as_float(w & 0xffff0000u); }
__device__ __forceinline__ f32x2 gelu_pk(f32x2 v) {
    const f32x2 av = __builtin_elementwise_abs(v), d = av * 0.2316418882f + 1.0f;
    f32x2 t; t.x = __builtin_amdgcn_rcpf(d.x); t.y = __builtin_amdgcn_rcpf(d.y);
    f32x2 q = t * 0.5307027145f + (-0.7265760135f); q = q * t + 0.7107068705f; q = q * t + (-0.142248368f); q = q * t + 0.127414796f; q = q * t;
    const f32x2 s = (v * v) * (-0.72134752044f);
    f32x2 e; e.x = __builtin_amdgcn_exp2f(s.x); e.y = __builtin_amdgcn_exp2f(s.y);
    const f32x2 m = v * (q * e), r = v - m;
    f32x2 o; o.x = v.x < 0.f ? m.x : r.x; o.y = v.y < 0.f ? m.y : r.y; return o;
}
__device__ __forceinline__ f32x4 gelu4(f32x4 v) { const f32x2 a = gelu_pk((f32x2){v[0], v[1]}), b = gelu_pk((f32x2){v[2], v[3]}); return (f32x4){a.x, a.y, b.x, b.y}; }
__device__ __forceinline__ float sigm(float x) { return __builtin_amdgcn_rcpf(1.0f + __builtin_amdgcn_exp2f(-1.4426950408889634f * x)); }
__device__ __forceinline__ f32x4 sigm4(f32x4 v) { return (f32x4){sigm(v[0]), sigm(v[1]), sigm(v[2]), sigm(v[3])}; }
__device__ __forceinline__ f32x4 silu4(f32x4 v) { return v * sigm4(v); }

template <class Epi, class Sched, bool ALIGN_EPI = false, bool SP2 = false>
__device__ __forceinline__ void gemm_phase(PG8_LAS unsigned char* lds, const Sched& S, const Epi& E) {
    const int tid = threadIdx.x, wid = __builtin_amdgcn_readfirstlane(tid >> 6), lane = tid & 63, wr = wid >> 2, wc = wid & 3, fr = lane & 15, fq = lane >> 4;
    int nt = 0; constexpr int lda = 2048, ldb = 2048;
    unsigned voffA[2], voffB[2];
#pragma unroll
    for (int i = 0; i < 2; ++i) { int R, C; stage_rc(tid * 16 + i * 8192, R, C); const int Rb = Epi::PERM ? ((R & ~31) + perm32(R & 31)) : R;
        voffA[i] = (unsigned)(R * lda + C) * 2u; voffB[i] = (unsigned)(Rb * ldb + C) * 2u; }
    const size_t kstep = (size_t)(BK * 2);
    const size_t hstepA = (size_t)HALF * lda * 2, hstepB = (size_t)HALF * ldb * 2;
    const size_t tstepA = 2 * hstepA, tstepB = 2 * hstepB;
    const unsigned ldsw = (unsigned)wid * 1024u;
    const int aoff = lds_byte(wr * 64 + fr, fq * 8), boff = lds_byte(wc * 32 + fr, fq * 8);
#define PG8_SA(b, h) (((b) * 2 + (h)) * HTB)
#define PG8_SB(b, h) ((4 + (b) * 2 + (h)) * HTB)
#define PG8_STAGE(bufoff, gbase, voff) do { _Pragma("unroll") for (int _i = 0; _i < 2; ++_i) \
        __builtin_amdgcn_global_load_lds((const unsigned*)((const char*)(gbase) + (voff)[_i]), (PG8_LAS unsigned*)(lds + (bufoff) + ldsw + _i * 8192), 16, 0, 0); } while (0)
#define PG8_LDA(dst, b, h) do { _Pragma("unroll") for (int m = 0; m < 4; ++m) _Pragma("unroll") for (int k = 0; k < 2; ++k) dst[m][k] = *(const PG8_LAS bf16x8*)(lds + PG8_SA(b, h) + aoff + m * 2048 + k * 1024); } while (0)
#define PG8_LDB(dst, b, h) do { _Pragma("unroll") for (int n = 0; n < 2; ++n) _Pragma("unroll") for (int k = 0; k < 2; ++k) dst[n][k] = *(const PG8_LAS bf16x8*)(lds + PG8_SB(b, h) + boff + n * 2048 + k * 1024); } while (0)
#define PG8_MMA(ai, bj, At, Bt) do { __builtin_amdgcn_s_setprio(1); _Pragma("unroll") for (int m = 0; m < 4; ++m) _Pragma("unroll") for (int n = 0; n < 2; ++n) _Pragma("unroll") for (int k = 0; k < 2; ++k) \
        acc[ai][bj][m][n] = __builtin_amdgcn_mfma_f32_16x16x32_bf16(Bt[n][k], At[m][k], acc[ai][bj][m][n], 0, 0, 0); __builtin_amdgcn_s_setprio(0); } while (0)
#define PG8_WAIT_V(n) asm volatile("s_waitcnt vmcnt(" #n ")" ::: "memory")
#define PG8_WAIT_L(n) asm volatile("s_waitcnt lgkmcnt(" #n ")" ::: "memory")
#define PG8_BAR __builtin_amdgcn_s_barrier()
#define PG8_SCHED __builtin_amdgcn_sched_barrier(0)
    Unit cur, nxt; int ui = 0;
    if (!S.next(0, cur)) return;
    f32x4 acc[2][2][4][2];
#pragma unroll
    for (int a = 0; a < 2; ++a)
#pragma unroll
        for (int b = 0; b < 2; ++b)
#pragma unroll
            for (int m = 0; m < 4; ++m)
#pragma unroll
                for (int n = 0; n < 2; ++n) acc[a][b][m][n] = (f32x4){0.f, 0.f, 0.f, 0.f};
    bf16x8 At[4][2], B0[2][2], B1[2][2];
    const char* cA; const char* cB; S.operands(cur, cA, cB, nt);
    S.a_ready(cur);
    if constexpr (SP2) {
        PG8_STAGE(PG8_SB(0, 0), cB, voffB); PG8_STAGE(PG8_SB(0, 1), cB + hstepB, voffB); PG8_STAGE(PG8_SA(0, 0), cA, voffA); PG8_STAGE(PG8_SA(0, 1), cA + hstepA, voffA);
        if (wr == 1) PG8_BAR;
        PG8_WAIT_V(2); PG8_BAR;
        PG8_STAGE(PG8_SB(1, 0), cB + kstep, voffB); PG8_STAGE(PG8_SA(1, 0), cA + kstep, voffA); PG8_STAGE(PG8_SB(1, 1), cB + hstepB + kstep, voffB);
        PG8_WAIT_V(6); PG8_BAR;
    } else {
        PG8_STAGE(PG8_SB(0, 0), cB, voffB); PG8_STAGE(PG8_SA(0, 0), cA, voffA); PG8_STAGE(PG8_SB(0, 1), cB + hstepB, voffB); PG8_STAGE(PG8_SA(0, 1), cA + hstepA, voffA);
        if (wr == 1) PG8_BAR;
        PG8_WAIT_V(4); PG8_BAR;
        PG8_STAGE(PG8_SB(1, 0), cB + kstep, voffB); PG8_STAGE(PG8_SA(1, 0), cA + kstep, voffA); PG8_STAGE(PG8_SB(1, 1), cB + hstepB + kstep, voffB);
        PG8_WAIT_V(6); PG8_BAR;
    }
    for (;;) {
        const bool has_next = S.next(ui + 1, nxt);
        const char* nA = cA; const char* nB = cB; int nnt = nt; if (has_next) S.operands(nxt, nA, nB, nnt);
        for (int t = 0; t < nt; t += 2) {
            const bool last = (t == nt - 2);
            const char* a1 = cA + (size_t)(t + 1) * kstep;
            const char* a2 = last ? nA : cA + (size_t)(t + 2) * kstep; const char* b2 = last ? nB : cB + (size_t)(t + 2) * kstep;
            const char* a3 = a2 + kstep; const char* b3 = b2 + kstep;
            if (last && has_next) S.a_ready(nxt);
            if constexpr (SP2) {
            PG8_LDB(B0, 0, 0); PG8_LDB(B1, 0, 1); PG8_SCHED; PG8_LDA(At, 0, 0); PG8_STAGE(PG8_SA(1, 1), a1 + hstepA, voffA);
            PG8_WAIT_V(8); PG8_WAIT_L(0); PG8_BAR; PG8_MMA(0, 0, At, B0); PG8_MMA(0, 1, At, B1); PG8_BAR; PG8_SCHED;
            PG8_LDA(At, 0, 1); PG8_STAGE(PG8_SB(0, 0), b2, voffB); PG8_STAGE(PG8_SB(0, 1), b2 + hstepB, voffB); PG8_STAGE(PG8_SA(0, 0), a2, voffA);
            PG8_WAIT_V(8); PG8_WAIT_L(0); PG8_BAR; PG8_MMA(1, 0, At, B0); PG8_MMA(1, 1, At, B1); PG8_BAR; PG8_SCHED;
            PG8_LDB(B0, 1, 0); PG8_LDB(B1, 1, 1); PG8_SCHED; PG8_LDA(At, 1, 0); PG8_STAGE(PG8_SA(0, 1), a2 + hstepA, voffA);
            PG8_WAIT_V(8); PG8_WAIT_L(0); PG8_BAR; PG8_MMA(0, 0, At, B0); PG8_MMA(0, 1, At, B1); PG8_BAR; PG8_SCHED;
            PG8_LDA(At, 1, 1); PG8_STAGE(PG8_SB(1, 0), b3, voffB); PG8_STAGE(PG8_SB(1, 1), b3 + hstepB, voffB); PG8_STAGE(PG8_SA(1, 0), a3, voffA);
            PG8_WAIT_V(8); PG8_WAIT_L(0); PG8_BAR; PG8_MMA(1, 0, At, B0); PG8_MMA(1, 1, At, B1); PG8_BAR; PG8_SCHED;
            } else {
            PG8_LDB(B0, 0, 0); PG8_SCHED; PG8_LDA(At, 0, 0); PG8_STAGE(PG8_SA(1, 1), a1 + hstepA, voffA);
            PG8_WAIT_L(8); PG8_BAR; PG8_WAIT_L(0); PG8_MMA(0, 0, At, B0); PG8_BAR; PG8_SCHED;
            PG8_LDB(B1, 0, 1); PG8_STAGE(PG8_SB(0, 0), b2, voffB);
            PG8_BAR; PG8_WAIT_L(0); PG8_MMA(0, 1, At, B1); PG8_BAR;
            PG8_LDA(At, 0, 1); PG8_STAGE(PG8_SA(0, 0), a2, voffA);
            PG8_BAR; PG8_WAIT_L(0); PG8_MMA(1, 0, At, B0); PG8_BAR; PG8_SCHED;
            PG8_STAGE(PG8_SB(0, 1), b2 + hstepB, voffB);
            PG8_WAIT_V(6); PG8_BAR; PG8_MMA(1, 1, At, B1); PG8_BAR;
            PG8_LDB(B0, 1, 0); PG8_SCHED; PG8_LDA(At, 1, 0); PG8_STAGE(PG8_SA(0, 1), a2 + hstepA, voffA);
            PG8_WAIT_L(8); PG8_BAR; PG8_WAIT_L(0); PG8_MMA(0, 0, At, B0); PG8_BAR; PG8_SCHED;
            PG8_LDB(B1, 1, 1); PG8_STAGE(PG8_SB(1, 0), b3, voffB);
            PG8_BAR; PG8_WAIT_L(0); PG8_MMA(0, 1, At, B1); PG8_BAR;
            PG8_LDA(At, 1, 1); PG8_STAGE(PG8_SA(1, 0), a3, voffA);
            PG8_BAR; PG8_WAIT_L(0); PG8_MMA(1, 0, At, B0); PG8_BAR; PG8_SCHED;
            PG8_STAGE(PG8_SB(1, 1), b3 + hstepB, voffB);
            PG8_WAIT_V(6); PG8_BAR; PG8_MMA(1, 1, At, B1); PG8_BAR;
            }
        }
        if constexpr (ALIGN_EPI) { if (wr == 0) PG8_BAR; }
        if constexpr (!Epi::AFTER_DRAIN) { E(acc, cur, wr, wc, fr, fq); S.done(cur); }
        if (!has_next) break;
        if (Epi::zero_after(cur)) {
#pragma unroll
        for (int a = 0; a < 2; ++a)
#pragma unroll
            for (int b = 0; b < 2; ++b)
#pragma unroll
                for (int m = 0; m < 4; ++m)
#pragma unroll
                    for (int n = 0; n < 2; ++n) acc[a][b][m][n] = (f32x4){0.f, 0.f, 0.f, 0.f};
        }
        cur = nxt; cA = nA; cB = nB; nt = nnt; ++ui;
        if constexpr (ALIGN_EPI) { if (wr == 1) PG8_BAR; }
    }
    PG8_WAIT_V(0);
    if constexpr (!ALIGN_EPI) { if (wr == 0) PG8_BAR; }
    PG8_BAR;
    if constexpr (Epi::AFTER_DRAIN) { E.fused(acc, cur, wr, wc, fr, fq, lds, wid, lane); S.done(cur); }
#undef PG8_SA
#undef PG8_SB
#undef PG8_STAGE
#undef PG8_LDA
#undef PG8_LDB
#undef PG8_MMA
#undef PG8_WAIT_V
#undef PG8_WAIT_L
#undef PG8_BAR
#undef PG8_SCHED
}}

using pg8::bf16_t; using pg8::bf16x8; using pg8::f32x4; using pg8::f32x2; using pg8::u32x4; using pg8::u32x2; using pg8::Unit;
#define LAS __attribute__((address_space(3)))
typedef short s16x4 __attribute__((ext_vector_type(4)));

constexpr int NWAVES = 8, NTHR = 512;
constexpr int DM = 2048, NB = 8, SEQ = 2048, DB = 128, DS = 8, PAST = 8192;
constexpr int MP = NB * SEQ, MS = DB * DS, M = MP + MS;
constexpr int AW = 1024, NG = 8, CH = 128, HD = 64, NH = 16, NKV = 4, BW = 1024, KVW = 256, WIN = 128;
constexpr int INC = 3 * AW + 2 * BW + 2 * KVW + 2 * DM;
constexpr int Z1W = 5632, GW = 4096;
constexpr int C_U = 0, C_V = 2048, C_Q = 3072, C_K = 4096, C_VA = 4352, C_ZB = 4608;
constexpr float EPS = 1e-6f;
constexpr float QSCALE = 0.125f * 1.4426950408889634f;
constexpr float LOG2E = 1.4426950408889634f;
constexpr int NTPOS = SEQ + DS;

constexpr size_t O_Y = 0, O_KWP = (size_t)M * DM, O_VWP = O_KWP + (size_t)NB * WIN * KVW, O_KWS = O_VWP + (size_t)NB * WIN * KVW,
                 O_VWS = O_KWS + (size_t)DB * WIN * KVW, O_CV = O_VWS + (size_t)DB * WIN * KVW, O_END = O_CV + (size_t)MS * AW;

constexpr size_t al256(size_t x) { return (x + 255) & ~(size_t)255; }
constexpr size_t WS_CTL = 0, CTL_ZERO_BYTES = 16384;
constexpr size_t WS_ROPE = CTL_ZERO_BYTES;
constexpr size_t WS_STATS = al256(WS_ROPE + (size_t)NTPOS * 32 * 2 * 4);
constexpr size_t WS_SSQ = al256(WS_STATS + (size_t)M * 32 * 4);
constexpr size_t WS_WIN = al256(WS_SSQ + (size_t)M * 32 * 4);
constexpr size_t WS_WP = al256(WS_WIN + (size_t)INC * DM * 2);
constexpr size_t WS_WOUT = al256(WS_WP + (size_t)DM * 2048 * 2);
constexpr size_t WS_H = al256(WS_WOUT + (size_t)DM * DM * 2);
constexpr size_t WS_Z1 = al256(WS_H + (size_t)M * DM * 2);
constexpr size_t WS_G = al256(WS_Z1 + (size_t)M * Z1W * 2);
constexpr size_t WS_END = al256(WS_G + (size_t)M * GW * 2);

constexpr int LDS_BYTES = 139264;

enum { T_U = 0, T_V, T_ZA, T_Q, T_K, T_VA, T_ZB, T_G };
struct EpiIn {
    static constexpr bool PERM = true, AFTER_DRAIN = false;
    static __device__ __forceinline__ bool zero_after(const Unit&) { return true; }
    bf16_t* Z1; bf16_t* G; float* stats; const float* rope; float* out;
    template <int TY> __device__ __forceinline__ void tile(f32x4 (&acc)[2][2][4][2], const Unit& u, int wr, int wc, int fr, int fq) const {
        const int cl = wc * 32 + 8 * fq; const int i0 = (16 * wc + 4 * fq) & 31;
        f32x4 rcs[2][4][2];
        if (TY == T_Q || TY == T_K) {
#pragma unroll
            for (int ai = 0; ai < 2; ++ai)
#pragma unroll
                for (int m = 0; m < 4; ++m) { const int row = u.pm * 256 + ai * 128 + wr * 64 + m * 16 + fr;
                    const int tpos = row < MP ? (row & (SEQ - 1)) : SEQ + ((row - MP) & (DS - 1));
                    const f32x4* rp = (const f32x4*)(rope + ((size_t)tpos * 32 + i0) * 2); rcs[ai][m][0] = rp[0]; rcs[ai][m][1] = rp[1]; }
        }
#pragma unroll
        for (int ai = 0; ai < 2; ++ai)
#pragma unroll
            for (int m = 0; m < 4; ++m) {
                const int row = u.pm * 256 + ai * 128 + wr * 64 + m * 16 + fr;
                f32x4 rc0 = {0.f, 0.f, 0.f, 0.f}, rc1 = {0.f, 0.f, 0.f, 0.f};
                if (TY == T_Q || TY == T_K) { rc0 = rcs[ai][m][0]; rc1 = rcs[ai][m][1]; }
                float ss = 0.f, sq = 0.f;
                bool win = false; size_t wbase = 0; float* wk = nullptr;
                if (TY == T_K || TY == T_VA) {
                    if (row < MP) { const int t = row & (SEQ - 1); win = t >= SEQ - WIN; wbase = ((size_t)(row >> 11) * WIN + (t - (SEQ - WIN))) * KVW; wk = out + (TY == T_K ? O_KWP : O_VWP); }
                    else { const int r = row - MP; win = true; wbase = ((size_t)(r >> 3) * WIN + (WIN - DS) + (r & 7)) * KVW; wk = out + (TY == T_K ? O_KWS : O_VWS); }
                }
#pragma unroll
                for (int bj = 0; bj < 2; ++bj) {
                    f32x4 a = acc[ai][bj][m][0], b = acc[ai][bj][m][1];
                    const int col = u.pn * 256 + bj * 128 + cl;
                    if (TY == T_U || TY == T_V) { a = pg8::gelu4(a); b = pg8::gelu4(b); }
                    if (TY == T_V) { ss += (a[0] + a[1]) + (a[2] + a[3]) + (b[0] + b[1]) + (b[2] + b[3]);
                        sq += (a[0] * a[0] + a[1] * a[1]) + (a[2] * a[2] + a[3] * a[3]) + (b[0] * b[0] + b[1] * b[1]) + (b[2] * b[2] + b[3] * b[3]); }
                    if (TY == T_ZA || TY == T_ZB) { a = pg8::silu4(a); b = pg8::silu4(b); }
                    if (TY == T_G) { a = pg8::sigm4(a); b = pg8::sigm4(b); }
                    if (TY == T_Q || TY == T_K) {
                        f32x4 ra, rb;
                        ra[0] = a[0] * rc0[0] - a[1] * rc0[1]; ra[1] = a[1] * rc0[0] + a[0] * rc0[1];
                        ra[2] = a[2] * rc0[2] - a[3] * rc0[3]; ra[3] = a[3] * rc0[2] + a[2] * rc0[3];
                        rb[0] = b[0] * rc1[0] - b[1] * rc1[1]; rb[1] = b[1] * rc1[0] + b[0] * rc1[1];
                        rb[2] = b[2] * rc1[2] - b[3] * rc1[3]; rb[3] = b[3] * rc1[2] + b[2] * rc1[3];
                        a = ra; b = rb;
                        if (TY == T_Q) { a = a * QSCALE; b = b * QSCALE; }
                    }
                    if (TY == T_K) { if (win) { float* o = wk + wbase + (bj * 2 + (wc >> 1)) * HD + i0;
                        *(f32x4*)o = (f32x4){a[0], a[2], b[0], b[2]}; *(f32x4*)(o + 32) = (f32x4){a[1], a[3], b[1], b[3]}; } }
                    if (TY == T_VA) { if (win) { float* o = wk + wbase + (bj * 2 + (wc >> 1)) * HD + (cl & 63); *(f32x4*)o = a; *(f32x4*)(o + 4) = b; } }
                    const u32x4 w = pg8::pack8(a, b);
                    if (TY == T_G) *(u32x4*)(G + (size_t)row * GW + (col - Z1W)) = w;
                    else *(u32x4*)(Z1 + (size_t)row * Z1W + col) = w;
                }
                if (TY == T_V) {
                    ss += __shfl_xor(ss, 16); ss += __shfl_xor(ss, 32); sq += __shfl_xor(sq, 16); sq += __shfl_xor(sq, 32);
                    if (fq == 0) *(f32x2*)(stats + ((size_t)row * 16 + (u.pn - 8) * 4 + wc) * 2) = (f32x2){ss, sq};
                }
            }
    }
    __device__ __forceinline__ void tile_uz(f32x4 (&acc)[2][2][4][2], const Unit& u, int wr, int wc, int fr, int fq) const {
        const int c = u.pn * 128 + wc * 32 + 8 * fq;
#pragma unroll
        for (int ai = 0; ai < 2; ++ai)
#pragma unroll
            for (int m = 0; m < 4; ++m) {
                const int row = u.pm * 256 + ai * 128 + wr * 64 + m * 16 + fr;
                const f32x4 p0 = pg8::gelu4(acc[ai][0][m][0]) * pg8::silu4(acc[ai][1][m][0]), p1 = pg8::gelu4(acc[ai][0][m][1]) * pg8::silu4(acc[ai][1][m][1]);
                *(u32x4*)(Z1 + (size_t)row * Z1W + C_U + c) = pg8::pack8(p0, p1);
            }
    }
    __device__ __forceinline__ void tile_gate(f32x4 (&acc)[2][2][4][2], const Unit& u, int wr, int wc, int fr, int fq) const {
        const int c = (u.pn - 22) * 128 + wc * 32 + 8 * fq;
#pragma unroll
        for (int ai = 0; ai < 2; ++ai)
#pragma unroll
            for (int m = 0; m < 4; ++m) {
                const int row = u.pm * 256 + ai * 128 + wr * 64 + m * 16 + fr;
                const f32x4 sa0 = pg8::sigm4(acc[ai][0][m][0]), sa1 = pg8::sigm4(acc[ai][0][m][1]), sb0 = pg8::sigm4(acc[ai][1][m][0]), sb1 = pg8::sigm4(acc[ai][1][m][1]);
                f32x4 r0, r1;
#pragma unroll
                for (int j = 0; j < 4; ++j) { r0[j] = sa0[j] * __builtin_amdgcn_rcpf(sb0[j]); r1[j] = sa1[j] * __builtin_amdgcn_rcpf(sb1[j]); }
                bf16_t* o = G + (size_t)row * GW + c;
                *(u32x4*)o = pg8::pack8(r0, r1); *(u32x4*)(o + DM) = pg8::pack8(sb0, sb1);
            }
    }
    __device__ __forceinline__ void operator()(f32x4 (&acc)[2][2][4][2], const Unit& u, int wr, int wc, int fr, int fq) const {
        asm volatile("" : "+v"(fr), "+v"(fq));
        const int pn = u.pn;
        if (pn < 8) tile_uz(acc, u, wr, wc, fr, fq);
        else if (pn < 12) tile<T_V>(acc, u, wr, wc, fr, fq);
        else if (pn < 16) tile<T_Q>(acc, u, wr, wc, fr, fq);
        else if (pn == 16) tile<T_K>(acc, u, wr, wc, fr, fq);
        else if (pn == 17) tile<T_VA>(acc, u, wr, wc, fr, fq);
        else if (pn < 22) tile<T_ZB>(acc, u, wr, wc, fr, fq);
        else tile_gate(acc, u, wr, wc, fr, fq);
    }
};
__device__ __forceinline__ void unpack8(u32x4 w, f32x4& a, f32x4& b) {
    a = (f32x4){pg8::bf_lo(w.x), pg8::bf_hi(w.x), pg8::bf_lo(w.y), pg8::bf_hi(w.y)}; b = (f32x4){pg8::bf_lo(w.z), pg8::bf_hi(w.z), pg8::bf_lo(w.w), pg8::bf_hi(w.w)};
}
__device__ __forceinline__ void store16_sc1(void* p, u32x4 v) { asm volatile("global_store_dwordx4 %0, %1, off sc1" :: "v"(p), "v"(v) : "memory"); }
struct EpiMerge {
    const bf16_t* G; bf16_t* MG; unsigned* mgcnt;
    __device__ __forceinline__ void operator()(f32x4 (&acc)[2][2][4][2], const Unit& u, int wr, int wc, int fr, int fq) const {
        asm volatile("" : "+v"(fr), "+v"(fq));
        const int cl = wc * 32 + 8 * fq; const int row0 = u.pm * 256 + wr * 64 + fr;
        const bf16_t* gp = G + (size_t)row0 * GW + u.pn * 256 + cl;
        if (u.kh == 0) {
#pragma unroll
            for (int ai = 0; ai < 2; ++ai)
#pragma unroll
                for (int m = 0; m < 4; ++m)
#pragma unroll
                    for (int bj = 0; bj < 2; ++bj) {
                        const bf16_t* p = gp + (size_t)(ai * 128 + m * 16) * GW + bj * 128;
                        f32x4 r0, r1; unpack8(*(const u32x4*)p, r0, r1);
                        acc[ai][bj][m][0] *= r0; acc[ai][bj][m][1] *= r1;
                    }
        } else {
            u32x4 sbw[2][4][2];
#pragma unroll
            for (int ai = 0; ai < 2; ++ai)
#pragma unroll
                for (int m = 0; m < 4; ++m)
#pragma unroll
                    for (int bj = 0; bj < 2; ++bj) sbw[ai][m][bj] = *(const u32x4*)(gp + (size_t)(ai * 128 + m * 16) * GW + bj * 128 + DM);
            asm volatile("" ::: "memory");
            bf16_t* op = MG + (size_t)row0 * DM + u.pn * 256 + cl;
#pragma unroll
            for (int ai = 0; ai < 2; ++ai)
#pragma unroll
                for (int m = 0; m < 4; ++m)
#pragma unroll
                    for (int bj = 0; bj < 2; ++bj) { f32x4 sb0, sb1; unpack8(sbw[ai][m][bj], sb0, sb1);
                        *(u32x4*)(op + (size_t)(ai * 128 + m * 16) * DM + bj * 128) = pg8::pack8(acc[ai][bj][m][0] * sb0, acc[ai][bj][m][1] * sb1); }
            asm volatile("s_waitcnt vmcnt(0)" ::: "memory");
            if (fr == 0 && fq == 0) (void)__hip_atomic_fetch_add(mgcnt + 64 * u.pm, 1u, __ATOMIC_RELAXED, __HIP_MEMORY_SCOPE_AGENT);
        }
    }
};
struct EpiOutNorm {
    const float* xp; const float* xs; const float* g_post; float* Y; unsigned* rowss;
    template <int B> __device__ __forceinline__ void ldx(f32x4 (&xb)[2][2], const float* Xl) const {
#pragma unroll
        for (int bj = 0; bj < 2; ++bj) { const float* p = Xl + (size_t)((B >> 2) * 128 + (B & 3) * 16) * DM + bj * 128; xb[bj][0] = *(const f32x4*)p; xb[bj][1] = *(const f32x4*)(p + 4); }
    }
    template <int B> __device__ __forceinline__ void stx(const f32x4 (&xb)[2][2], f32x4 (&acc)[2][2][4][2], float* Yl, const float (&rstd)[8], const f32x4 (&gv)[2][2]) const {
#pragma unroll
        for (int bj = 0; bj < 2; ++bj) { constexpr int ai = B >> 2, m = B & 3; float* o = Yl + (size_t)(ai * 128 + m * 16) * DM + bj * 128; const float r = rstd[B];
            *(f32x4*)o = xb[bj][0] + acc[ai][bj][m][0] * r * gv[bj][0]; *(f32x4*)(o + 4) = xb[bj][1] + acc[ai][bj][m][1] * r * gv[bj][1]; }
    }
    __device__ __forceinline__ void operator()(f32x4 (&acc)[2][2][4][2], const Unit& u, int wr, int wc, int fr, int fq) const {
        asm volatile("" : "+v"(fr), "+v"(fq));
        const int cl = wc * 32 + 8 * fq; const int rbase = u.pm * 256 + wr * 64 + fr;
        const float* X = (u.pm < MP / 256) ? xp + (size_t)u.pm * 256 * DM : xs + (size_t)(u.pm - MP / 256) * 256 * DM;
        const float* Xl = X + (size_t)(wr * 64 + fr) * DM + u.pn * 256 + cl; float* Yl = Y + (size_t)rbase * DM + u.pn * 256 + cl;
        f32x4 xb0[2][2], xb1[2][2], xb2[2][2];
        ldx<0>(xb0, Xl);
        f32x4 gv[2][2];
#pragma unroll
        for (int bj = 0; bj < 2; ++bj) { gv[bj][0] = *(const f32x4*)(g_post + u.pn * 256 + bj * 128 + cl); gv[bj][1] = *(const f32x4*)(g_post + u.pn * 256 + bj * 128 + cl + 4); }
        unsigned long long* rs = (unsigned long long*)rowss + rbase;
#pragma unroll
        for (int ai = 0; ai < 2; ++ai)
#pragma unroll
            for (int m = 0; m < 4; ++m) {
                float sq = 0.f;
#pragma unroll
                for (int bj = 0; bj < 2; ++bj) { const f32x4 a = acc[ai][bj][m][0], b = acc[ai][bj][m][1];
                    sq += (a[0] * a[0] + a[1] * a[1]) + (a[2] * a[2] + a[3] * a[3]) + (b[0] * b[0] + b[1] * b[1]) + (b[2] * b[2] + b[3] * b[3]); }
                sq += __shfl_xor(sq, 16); sq += __shfl_xor(sq, 32);
                if (fq == 0) (void)__hip_atomic_fetch_add(rs + ai * 128 + m * 16, (1ull << 56) + (unsigned long long)(sq * 16777216.0f + 0.5f), __ATOMIC_RELAXED, __HIP_MEMORY_SCOPE_AGENT);
            }
        float rstd[8];
        { unsigned long long v[8]; unsigned spins = 0;
          for (;;) { bool ok = true;
#pragma unroll
              for (int i = 0; i < 8; ++i) { v[i] = __hip_atomic_load(rs + (i >> 2) * 128 + (i & 3) * 16, __ATOMIC_RELAXED, __HIP_MEMORY_SCOPE_AGENT); ok = ok && ((v[i] >> 56) == 32ull); }
              if (__all(ok) || ++spins > (1u << 17)) break;
              __builtin_amdgcn_s_sleep(1); }
#pragma unroll
          for (int i = 0; i < 8; ++i) rstd[i] = __builtin_amdgcn_rsqf((float)(v[i] & ((1ull << 56) - 1)) * (1.0f / (16777216.0f * DM)) + EPS); }
#define FENCE_ asm volatile("" ::: "memory")
        ldx<1>(xb1, Xl); ldx<2>(xb2, Xl); FENCE_; stx<0>(xb0, acc, Yl, rstd, gv); FENCE_;
        ldx<3>(xb0, Xl); FENCE_; stx<1>(xb1, acc, Yl, rstd, gv); FENCE_;
        ldx<4>(xb1, Xl); FENCE_; stx<2>(xb2, acc, Yl, rstd, gv); FENCE_;
        ldx<5>(xb2, Xl); FENCE_; stx<3>(xb0, acc, Yl, rstd, gv); FENCE_;
        ldx<6>(xb0, Xl); FENCE_; stx<4>(xb1, acc, Yl, rstd, gv); FENCE_;
        ldx<7>(xb1, Xl); FENCE_; stx<5>(xb2, acc, Yl, rstd, gv); FENCE_;
        stx<6>(xb0, acc, Yl, rstd, gv); stx<7>(xb1, acc, Yl, rstd, gv);
#undef FENCE_
    }
};

struct MOOrder {
    int c; const bf16_t *AB, *WpT, *MG, *WoutT; const unsigned* mgcnt;
    __device__ bool next(int i, Unit& u) const {
        const int j = c >> 3; u.pn = c & 7;
        const int n3 = ((j & 3) == 0 && j < 16) ? 3 : 2, n4 = ((j & 3) == 1 && j < 16) ? 3 : 2;
        if (i < 2 * n3) { const int t = i >> 1; u.kh = i & 1; u.ty = 0; u.pm = (t < 2) ? j + 32 * t : 64 + (j >> 2); return true; }
        const int k = i - 2 * n3; if (k >= n4) return false;
        u.kh = 0; u.ty = 1; u.pm = (k < 2) ? j + 32 * k : 64 + (j >> 2); return true;
    }
    __device__ __forceinline__ void operands(const Unit& u, const char*& A, const char*& B, int& nt) const {
        if (u.ty == 0) { A = (const char*)(AB + u.kh * AW) + (size_t)u.pm * pg8::TSTEP; B = (const char*)(WpT + u.kh * AW) + (size_t)u.pn * pg8::TSTEP; nt = AW / 64; }
        else { A = (const char*)MG + (size_t)u.pm * pg8::TSTEP; B = (const char*)WoutT + (size_t)u.pn * pg8::TSTEP; nt = DM / 64; }
    }
    __device__ __forceinline__ void a_ready(const Unit& u) const {
        if (u.ty != 1) return;
        if (threadIdx.x < 64) {
            unsigned spins = 0;
            while ((unsigned)__builtin_amdgcn_readfirstlane(__hip_atomic_load(mgcnt + 64 * u.pm, __ATOMIC_RELAXED, __HIP_MEMORY_SCOPE_AGENT)) < 64u) { __builtin_amdgcn_s_sleep(2); if (++spins > (1u << 17)) break; }
            __builtin_amdgcn_fence(__ATOMIC_ACQUIRE, "agent");
            asm volatile("s_waitcnt vmcnt(0)" ::: "memory");
        }
        asm volatile("" ::: "memory"); __builtin_amdgcn_s_barrier(); asm volatile("" ::: "memory");
    }
    __device__ __forceinline__ void done(const Unit&) const {}
};
struct EpiMO {
    static constexpr bool PERM = true, AFTER_DRAIN = false;
    static __device__ __forceinline__ bool zero_after(const Unit& u) { return u.ty == 1 || u.kh == 1; }
    EpiMerge em; EpiOutNorm eo;
    __device__ __forceinline__ void operator()(f32x4 (&acc)[2][2][4][2], const Unit& u, int wr, int wc, int fr, int fq) const {
        if (u.ty == 0) em(acc, u, wr, wc, fr, fq); else eo(acc, u, wr, wc, fr, fq);
    }
};
#define XB_TMO      128
#define XB_XCNT(j)  (256  + 64 * (j))
#define XB_XSUB(j)  (1280 + 64 * (j))
#define XB_XGEN(j)  (2304 + 64 * (j))
#define XB_TOP      3328
#define XB_TOPGEN   3392
#define XCD_BAR_WORDS 3456
#define XB_SPIN_CAP (1u << 18)

__device__ __forceinline__ unsigned xb_ld(unsigned* p)              { return __hip_atomic_load(p, __ATOMIC_RELAXED, __HIP_MEMORY_SCOPE_AGENT); }
__device__ __forceinline__ unsigned xb_add(unsigned* p, unsigned v) { return __hip_atomic_fetch_add(p, v, __ATOMIC_RELAXED, __HIP_MEMORY_SCOPE_AGENT); }
__device__ __forceinline__ unsigned xb_xcc_id() { return (unsigned)__builtin_amdgcn_s_getreg((3 << 11) | 20) & 0xFu; }
#define XB_SPIN(cond, bar) do { unsigned _sp = 0; while (cond) { __builtin_amdgcn_s_sleep(1); \
    if ((++_sp & 255u) == 0u) { if (xb_ld(&(bar)[XB_TMO])) break; if (_sp > XB_SPIN_CAP) { atomicAdd(&(bar)[XB_TMO], 1u); break; } } } } while (0)

struct XcdBarrier {
    unsigned* bar; unsigned x;
    volatile LAS unsigned* st;
};

__device__ __forceinline__ XcdBarrier xcd_barrier_post(unsigned* bar, volatile LAS unsigned* st) {
    XcdBarrier b; b.bar = bar; b.x = xb_xcc_id(); b.st = st;
    if (threadIdx.x == 0) st[2] = xb_add(&bar[XB_XCNT(b.x)], 1u);
    return b;
}
__device__ __forceinline__ void xcd_barrier_complete(unsigned* bar, unsigned x, unsigned& nloc, unsigned& nx) {
    const unsigned G = gridDim.x * gridDim.y * gridDim.z;
    unsigned sum, cnt, mine, sp = 0u;
    for (;;) {
        sum = 0u; cnt = 0u; mine = 0u;
#pragma unroll
        for (unsigned j = 0; j < 16; ++j) { const unsigned c = xb_ld(&bar[XB_XCNT(j)]); sum += c; cnt += (c > 0u) ? 1u : 0u; mine = (j == x) ? c : mine; }
        if (sum == G) break;
        __builtin_amdgcn_s_sleep(1);
        if ((++sp & 255u) == 0u) { if (xb_ld(&bar[XB_TMO])) break; if (sp > XB_SPIN_CAP) { atomicAdd(&bar[XB_TMO], 1u); break; } }
    }
    nloc = mine > 0u ? mine : 1u; nx = cnt > 0u ? cnt : 1u;
}

__device__ __forceinline__ void xcd_barrier(const XcdBarrier& b) {
    asm volatile("s_waitcnt vmcnt(0)" ::: "memory");
    __syncthreads();
    if (threadIdx.x == 0) {
        unsigned* bar = b.bar;
        __builtin_amdgcn_s_waitcnt(0);
        unsigned nloc = b.st[0], nx = b.st[1];
        if (nloc == 0u) { xcd_barrier_complete(bar, b.x, nloc, nx); b.st[0] = nloc; b.st[1] = nx; }
        const unsigned old = xb_add(&bar[XB_XSUB(b.x)], 1u);
        const unsigned gen = old / nloc;
        if (old + 1u == (gen + 1u) * nloc) {
            __builtin_amdgcn_fence(__ATOMIC_RELEASE, "agent");
            asm volatile("s_waitcnt vmcnt(0)" ::: "memory");
            const unsigned og = xb_add(&bar[XB_TOP], 1u);
            const unsigned tg = og / nx;
            if (og + 1u == (tg + 1u) * nx) xb_add(&bar[XB_TOPGEN], 1u);
            else XB_SPIN(xb_ld(&bar[XB_TOPGEN]) == tg, bar);
            __builtin_amdgcn_fence(__ATOMIC_ACQUIRE, "agent");
            xb_add(&bar[XB_XGEN(b.x)], 1u);
            asm volatile("s_waitcnt vmcnt(0)" ::: "memory");
        } else {
            XB_SPIN(xb_ld(&bar[XB_XGEN(b.x)]) == gen, bar);
            __builtin_amdgcn_fence(__ATOMIC_ACQUIRE, "agent");
            asm volatile("s_waitcnt vmcnt(0)" ::: "memory");
        }
    }
    __syncthreads();
}

__device__ __forceinline__ float wave_sum(float v) {
#pragma unroll
    for (int o = 1; o < 64; o <<= 1) v += __shfl_xor(v, o);
    return v;
}
__device__ __forceinline__ unsigned f2bf(float f) { unsigned u = __float_as_uint(f); return (u + 0x7fffu + ((u >> 16) & 1u)) >> 16; }
__device__ __forceinline__ unsigned pk2(float lo, float hi) { return pg8::cvt_pk_bf16(lo, hi); }
__device__ __forceinline__ bf16_t pick16(u32x4 v, int idx) { const unsigned d01 = (idx & 2) ? v.y : v.x, d23 = (idx & 2) ? v.w : v.z, d = (idx & 4) ? d23 : d01; return (bf16_t)((idx & 1) ? (d >> 16) : (d & 0xffffu)); }
#define LDS_WAIT() asm volatile("s_waitcnt lgkmcnt(0)" ::: "memory")

struct Ptrs {
    const float *xp, *xs, *ck, *cv, *g_pre, *w_in, *ln_g, *ln_b, *w_sp, *b_sp, *sinks, *w_pa, *w_pb, *w_out, *g_post;
    float* out; unsigned char* ws;
};
static __device__ const double kInvFreq[32] = {1.0, 0.7498942093324559, 0.5623413251903491, 0.4216965034285822, 0.31622776601683794, 0.23713737056616552, 0.1778279410038923, 0.1333521432163324, 0.1, 0.07498942093324558, 0.05623413251903491, 0.042169650342858224, 0.03162277660168379, 0.023713737056616554, 0.01778279410038923, 0.01333521432163324, 0.01, 0.007498942093324558, 0.005623413251903491, 0.004216965034285823, 0.0031622776601683794, 0.0023713737056616554, 0.0017782794100389228, 0.001333521432163324, 0.001, 0.0007498942093324559, 0.0005623413251903491, 0.00042169650342858224, 0.00031622776601683794, 0.00023713737056616554, 0.00017782794100389227, 0.0001333521432163324};

template <bool QKPERM>
__device__ __forceinline__ void p0_transpose_item(const float* W, int N, bf16_t* WT, int ldt, int koff, LAS float* scr, int item, int lane) {
    const int nblk = N / 32, kb = item / nblk, nb = item % nblk, k0 = 64 * kb, n0 = 32 * nb;
#pragma unroll 8
    for (int i = 0; i < 32; ++i) { const int kk = 2 * i + (lane >> 5); scr[kk * 33 + (lane & 31)] = W[(size_t)(k0 + kk) * N + n0 + (lane & 31)]; }
    LDS_WAIT(); asm volatile("" ::: "memory");
    const int c = lane & 7;
#pragma unroll
    for (int j = 0; j < 4; ++j) { const int n = (lane >> 3) + 8 * j; const LAS float* s = scr + (8 * c) * 33 + n;
        u32x4 o; o.x = pk2(s[0 * 33], s[1 * 33]); o.y = pk2(s[2 * 33], s[3 * 33]); o.z = pk2(s[4 * 33], s[5 * 33]); o.w = pk2(s[6 * 33], s[7 * 33]);
        int nn = n0 + n;
        if (QKPERM) { if (nn >= C_Q && nn < C_VA) { const int d = nn & 63; nn = (nn & ~63) + 2 * (d & 31) + (d >> 5); } }
        if (QKPERM) { if (nn < 1024) nn = (nn >> 7) * 256 + (nn & 127); else if (nn < 2048) nn += 1024; else if (nn < 3072) { const int c = nn - 2048; nn = (c >> 7) * 256 + 128 + (c & 127); } }
        if (QKPERM) { if (nn >= Z1W) { const int c = nn - Z1W; nn = (c < DM) ? Z1W + (c >> 7) * 256 + (c & 127) : Z1W + ((c - DM) >> 7) * 256 + 128 + (c & 127); } }
        *(u32x4*)(WT + (size_t)nn * ldt + koff + k0 + 8 * c) = o; }
    LDS_WAIT(); asm volatile("" ::: "memory");
}
template <int PART>
__device__ __forceinline__ void p0_prologue(const Ptrs& P, LAS unsigned char* lds, int vcu, int G, int wave, int lane, int tid) {
    LAS float* scr = (LAS float*)(lds + wave * 16384);
    const int gw = vcu * NWAVES + wave, NGW = G * NWAVES;
    const int gt = vcu * NTHR + tid, NGT = G * NTHR;
    constexpr int I_IN = (DM / 64) * (INC / 32), I_PA = (AW / 64) * (DM / 32), I_PB = (BW / 64) * (DM / 32), I_OUT = (DM / 64) * (DM / 32);
    if (PART == 0) {
        bf16_t* WinT = (bf16_t*)(P.ws + WS_WIN);
        for (int it = gw; it < I_IN; it += NGW) p0_transpose_item<true>(P.w_in, INC, WinT, DM, 0, scr, it, lane);
        bf16_t* H = (bf16_t*)(P.ws + WS_H);
        for (int m = gw; m < M; m += NGW) {
            const float* xrow = m < MP ? P.xp + (size_t)m * DM : P.xs + (size_t)(m - MP) * DM;
            const f32x4* xr = (const f32x4*)xrow + lane; f32x4 v[8]; float s = 0.f;
#pragma unroll
            for (int j = 0; j < 8; ++j) { v[j] = xr[64 * j]; s += (v[j][0] * v[j][0] + v[j][1] * v[j][1]) + (v[j][2] * v[j][2] + v[j][3] * v[j][3]); }
            const float rstd = 1.0f / sqrtf(wave_sum(s) * (1.0f / DM) + EPS);
            u32x2* o = (u32x2*)(H + (size_t)m * DM) + lane;
#pragma unroll
            for (int j = 0; j < 8; ++j) { const f32x4 g = ((const f32x4*)P.g_pre)[lane + 64 * j]; const f32x4 y = v[j] * rstd * g; u32x2 w; w.x = pk2(y[0], y[1]); w.y = pk2(y[2], y[3]); o[64 * j] = w; }
        }
        float* rope = (float*)(P.ws + WS_ROPE);
        for (int e = gt; e < NTPOS * 32; e += NGT) {
            const int tp = e >> 5, i = e & 31; const int pos = tp < SEQ ? tp : PAST + (tp - SEQ);
            const double a = (double)pos * kInvFreq[i]; const double k = __builtin_rint(a * 0.15915494309189535); const float r = (float)(a - k * 6.283185307179586);
            *(f32x2*)(rope + (size_t)e * 2) = (f32x2){__cosf(r), __sinf(r)};
        }
        { unsigned* z = (unsigned*)(P.ws + WS_SSQ); for (int e = gt; e < 2 * M + 68 * 64; e += NGT) z[e] = 0u; }
    } else {
        bf16_t* WpT = (bf16_t*)(P.ws + WS_WP); bf16_t* WoutT = (bf16_t*)(P.ws + WS_WOUT);
        for (int it = gw; it < I_PA + I_PB + I_OUT; it += NGW) {
            int r = it;
            if (r < I_PA) { p0_transpose_item<false>(P.w_pa, DM, WpT, 2048, 0, scr, r, lane); continue; } r -= I_PA;
            if (r < I_PB) { p0_transpose_item<false>(P.w_pb, DM, WpT, 2048, 1024, scr, r, lane); continue; } r -= I_PB;
            p0_transpose_item<false>(P.w_out, DM, WoutT, DM, 0, scr, r, lane);
        }
        constexpr int NV = DB * (WIN - DS) * (KVW / 4);
        for (int e = gt; e < 2 * NV; e += NGT) {
            const int which = e >= NV; const int r = which ? e - NV : e; const int db = r / ((WIN - DS) * (KVW / 4)), q = r % ((WIN - DS) * (KVW / 4));
            const f32x4* src = (const f32x4*)(which ? P.cv : P.ck) + (size_t)db * WIN * (KVW / 4) + DS * (KVW / 4) + q;
            f32x4* dst = (f32x4*)(P.out + (which ? O_VWS : O_KWS)) + (size_t)db * WIN * (KVW / 4) + q;
            *dst = *src;
        }
    }
}

constexpr int KS_STRIDE = 72, VT_STRIDE = 264;
constexpr int A_STRIDE = 136;
struct QTileIn { bf16x8 qf0, qf1; u32x2 zw[4]; };
__device__ __forceinline__ QTileIn qtile_load(const bf16_t* qp, const bf16_t* zp, int lane) {
    const int quad = lane >> 4; QTileIn t; t.qf0 = *(const bf16x8*)(qp + quad * 8); t.qf1 = *(const bf16x8*)(qp + 32 + quad * 8);
#pragma unroll
    for (int dt = 0; dt < 4; ++dt) t.zw[dt] = *(const u32x2*)(zp + dt * 16 + quad * 4);
    return t;
}
template <int NKT, int MODE>
__device__ __forceinline__ void attn_qtile(const QTileIn& in, LAS const unsigned char* Ks, LAS const unsigned char* VTs, int lane, int qt, bool first, float sink2, bf16_t* op) {
    const int n = lane & 15, quad = lane >> 4;
    const bf16x8 qf0 = in.qf0, qf1 = in.qf1;
    f32x4 s[NKT];
    const int qi = (MODE == 0) ? qt * 16 + n : (n & 7);
#pragma unroll
    for (int kt = 0; kt < NKT; ++kt) {
        bool need;
        if (MODE == 0) need = (kt < 8) ? (!first && kt >= qt) : (kt - 8 <= qt); else need = kt < 9;
        s[kt] = (f32x4){-1e30f, -1e30f, -1e30f, -1e30f};
        if (need) {
            const LAS unsigned char* kp = Ks + (kt * 16 + n) * (KS_STRIDE * 2) + quad * 16;
            const bf16x8 k0 = *(const LAS bf16x8*)kp, k1 = *(const LAS bf16x8*)(kp + 64);
            f32x4 c = {0.f, 0.f, 0.f, 0.f};
            c = __builtin_amdgcn_mfma_f32_16x16x32_bf16(k0, qf0, c, 0, 0, 0);
            c = __builtin_amdgcn_mfma_f32_16x16x32_bf16(k1, qf1, c, 0, 0, 0);
#pragma unroll
            for (int j = 0; j < 4; ++j) { const int kk = kt * 16 + quad * 4 + j; bool vis;
                if (MODE == 0) vis = (kk < 128) ? (kk > qi) : (kk - 128 <= qi); else vis = (kk < 128) ? (kk > qi) : (kk - 128 <= qi);
                s[kt][j] = vis ? c[j] : -1e30f; }
        }
    }
    float mx = -1e30f;
#pragma unroll
    for (int kt = 0; kt < NKT; ++kt) mx = fmaxf(mx, fmaxf(fmaxf(s[kt][0], s[kt][1]), fmaxf(s[kt][2], s[kt][3])));
    mx = fmaxf(mx, __shfl_xor(mx, 16)); mx = fmaxf(mx, __shfl_xor(mx, 32)); mx = fmaxf(mx, sink2);
    float sum = 0.f;
#pragma unroll
    for (int kt = 0; kt < NKT; ++kt) {
#pragma unroll
        for (int j = 0; j < 4; ++j) { const float p = __builtin_amdgcn_exp2f(s[kt][j] - mx); s[kt][j] = p; sum += p; } }
    sum += __shfl_xor(sum, 16); sum += __shfl_xor(sum, 32); sum += __builtin_amdgcn_exp2f(sink2 - mx);
    const float inv = 1.0f / sum;
    f32x4 o[4];
#pragma unroll
    for (int dt = 0; dt < 4; ++dt) o[dt] = (f32x4){0.f, 0.f, 0.f, 0.f};
#pragma unroll
    for (int pp = 0; pp < NKT / 2; ++pp) {
        bool need;
        if (MODE == 0) need = (pp < 4) ? (!first && 2 * pp + 1 >= qt) : (2 * pp - 8 <= qt); else need = pp < 5;
        if (need) {
            u32x4 pw; pw.x = pk2(s[2 * pp][0], s[2 * pp][1]); pw.y = pk2(s[2 * pp][2], s[2 * pp][3]); pw.z = pk2(s[2 * pp + 1][0], s[2 * pp + 1][1]); pw.w = pk2(s[2 * pp + 1][2], s[2 * pp + 1][3]);
            const bf16x8 pf = __builtin_bit_cast(bf16x8, pw);
#pragma unroll
            for (int dt = 0; dt < 4; ++dt) {
                const LAS unsigned char* vp = VTs + (dt * 16 + n) * (VT_STRIDE * 2) + (pp * 32 + quad * 4) * 2;
                const u32x2 v0 = *(const LAS u32x2*)vp, v1 = *(const LAS u32x2*)(vp + 32);
                const u32x4 vw = {v0.x, v0.y, v1.x, v1.y};
                o[dt] = __builtin_amdgcn_mfma_f32_16x16x32_bf16(__builtin_bit_cast(bf16x8, vw), pf, o[dt], 0, 0, 0);
            }
        }
    }
#pragma unroll
    for (int dt = 0; dt < 4; ++dt) {
        const u32x2 zw = in.zw[dt];
        const f32x4 z = {pg8::bf_lo(zw.x), pg8::bf_hi(zw.x), pg8::bf_lo(zw.y), pg8::bf_hi(zw.y)};
        const f32x4 r = o[dt] * inv * z; u32x2 w; w.x = pk2(r[0], r[1]); w.y = pk2(r[2], r[3]);
        *(u32x2*)(op + dt * 16 + quad * 4) = w;
    }
}

struct QTile2In { bf16x8 qf[2][2]; u32x2 zw[2][4]; };
__device__ __forceinline__ void attn_qtile2(const QTile2In& in, LAS const unsigned char* Ks, LAS const unsigned char* VTs, int lane, int qt0, bool first, float sink2, bf16_t* op0) {
    const int n = lane & 15, quad = lane >> 4;
    f32x4 s[2][9];
#pragma unroll
    for (int T = 0; T < 2; ++T) {
        const int qt = qt0 + T; const int qi = qt * 16 + n;
        const LAS unsigned char* kb = Ks + (qt * 16 + n) * (KS_STRIDE * 2) + quad * 16;
#pragma unroll
        for (int r = 0; r < 9; ++r) {
            const LAS unsigned char* kp = kb + r * 16 * (KS_STRIDE * 2);
            const bf16x8 k0 = *(const LAS bf16x8*)kp, k1 = *(const LAS bf16x8*)(kp + 64);
            f32x4 c = {0.f, 0.f, 0.f, 0.f};
            c = __builtin_amdgcn_mfma_f32_16x16x32_bf16(k0, in.qf[T][0], c, 0, 0, 0);
            c = __builtin_amdgcn_mfma_f32_16x16x32_bf16(k1, in.qf[T][1], c, 0, 0, 0);
#pragma unroll
            for (int j = 0; j < 4; ++j) { const int kk = (qt + r) * 16 + quad * 4 + j; const bool vis = (kk < 128) ? (!first && kk > qi) : (kk - 128 <= qi);
                s[T][r][j] = vis ? c[j] : -1e30f; }
        }
    }
    float inv[2];
#pragma unroll
    for (int T = 0; T < 2; ++T) {
        float mx = -1e30f;
#pragma unroll
        for (int r = 0; r < 9; ++r) mx = fmaxf(mx, fmaxf(fmaxf(s[T][r][0], s[T][r][1]), fmaxf(s[T][r][2], s[T][r][3])));
        mx = fmaxf(mx, __shfl_xor(mx, 16)); mx = fmaxf(mx, __shfl_xor(mx, 32)); mx = fmaxf(mx, sink2);
        float sum = 0.f;
#pragma unroll
        for (int r = 0; r < 9; ++r) {
#pragma unroll
            for (int j = 0; j < 4; ++j) { const float p = __builtin_amdgcn_exp2f(s[T][r][j] - mx); s[T][r][j] = p; sum += p; } }
        sum += __shfl_xor(sum, 16); sum += __shfl_xor(sum, 32); sum += __builtin_amdgcn_exp2f(sink2 - mx);
        inv[T] = 1.0f / sum;
    }
#pragma unroll
    for (int T = 0; T < 2; ++T) {
        const int qt = qt0 + T;
        f32x4 o[4];
#pragma unroll
        for (int dt = 0; dt < 4; ++dt) o[dt] = (f32x4){0.f, 0.f, 0.f, 0.f};
#pragma unroll
        for (int pp = 0; pp < 5; ++pp) {
            u32x4 pw; pw.x = pk2(s[T][2 * pp][0], s[T][2 * pp][1]); pw.y = pk2(s[T][2 * pp][2], s[T][2 * pp][3]);
            if (pp < 4) { pw.z = pk2(s[T][2 * pp + 1][0], s[T][2 * pp + 1][1]); pw.w = pk2(s[T][2 * pp + 1][2], s[T][2 * pp + 1][3]); } else { pw.z = 0u; pw.w = 0u; }
            const bf16x8 pf = __builtin_bit_cast(bf16x8, pw);
#pragma unroll
            for (int dt = 0; dt < 4; ++dt) {
                const LAS unsigned char* vp = VTs + (dt * 16 + n) * (VT_STRIDE * 2) + ((qt + 2 * pp) * 16 + quad * 4) * 2;
                const u32x2 v0 = *(const LAS u32x2*)vp, v1 = *(const LAS u32x2*)(vp + (pp < 4 ? 32 : 0));
                const u32x4 vw = {v0.x, v0.y, v1.x, v1.y};
                o[dt] = __builtin_amdgcn_mfma_f32_16x16x32_bf16(__builtin_bit_cast(bf16x8, vw), pf, o[dt], 0, 0, 0);
            }
        }
        bf16_t* op = op0 + (size_t)T * 16 * 2048;
#pragma unroll
        for (int dt = 0; dt < 4; ++dt) {
            const u32x2 zw = in.zw[T][dt];
            const f32x4 z = {pg8::bf_lo(zw.x), pg8::bf_hi(zw.x), pg8::bf_lo(zw.y), pg8::bf_hi(zw.y)};
            const f32x4 rr = o[dt] * inv[T] * z; u32x2 w; w.x = pk2(rr[0], rr[1]); w.y = pk2(rr[2], rr[3]);
            *(u32x2*)(op + dt * 16 + quad * 4) = w;
        }
    }
}
__device__ __forceinline__ void p2_mixers(const Ptrs& P, LAS unsigned char* lds, int vcu, int G, int wave, int lane, int tid) {
    bf16_t* Z1 = (bf16_t*)(P.ws + WS_Z1); bf16_t* AB = (bf16_t*)(P.ws + WS_H); const float* stats = (const float*)(P.ws + WS_STATS);
    {
        LAS unsigned char* vnT = lds; LAS unsigned char* Wl = lds + 128 * A_STRIDE * 2; LAS float* mr = (LAS float*)(lds + 2 * 128 * A_STRIDE * 2);
        const int g = vcu & 7;
#pragma unroll
        for (int i = 0; i < 8; ++i) { const int e = tid + i * NTHR, t = e >> 5, s0 = (e & 31) * 4;
            const f32x4 w = *(const f32x4*)(P.w_sp + ((size_t)g * CH + t) * CH + s0);
            u32x2 o; o.x = pk2(s0 <= t ? w[0] : 0.f, s0 + 1 <= t ? w[1] : 0.f); o.y = pk2(s0 + 2 <= t ? w[2] : 0.f, s0 + 3 <= t ? w[3] : 0.f);
            *(LAS u32x2*)(Wl + t * (A_STRIDE * 2) + s0 * 2) = o; }
        const f32x4 lg0 = *(const f32x4*)(P.ln_g + g * CH + (tid & 15) * 8), lg1 = *(const f32x4*)(P.ln_g + g * CH + (tid & 15) * 8 + 4);
        const f32x4 lb0 = *(const f32x4*)(P.ln_b + g * CH + (tid & 15) * 8), lb1 = *(const f32x4*)(P.ln_b + g * CH + (tid & 15) * 8 + 4);
        u32x4 gvr[4]; f32x4 st0, st1;
#define A_PREFETCH(UN) do { const int row0_ = ((UN) >> 3) * CH; \
            _Pragma("unroll") for (int i = 0; i < 4; ++i) { const int e = tid + i * NTHR; gvr[i] = *(const u32x4*)(Z1 + (size_t)(row0_ + (e >> 4)) * Z1W + C_V + g * CH + (e & 15) * 8); } \
            const f32x4* sp_ = (const f32x4*)(stats + (size_t)(row0_ + (tid >> 2)) * 32) + (tid & 3) * 2; st0 = sp_[0]; st1 = sp_[1]; } while (0)
        int un = vcu;
        if (un < (MP / CH) * NG) A_PREFETCH(un);
        for (; un < (MP / CH) * NG; un += G) {
            const int row0 = (un >> 3) * CH;
            u32x2 uw[8];
            { const size_t zr_ = (size_t)(row0 + wave * 16 + (lane & 15)) * Z1W + g * CH + (lane >> 4) * 4;
#pragma unroll
              for (int ct = 0; ct < 8; ++ct) uw[ct] = *(const u32x2*)(Z1 + zr_ + C_U + ct * 16); }
            { float sm = (st0[0] + st0[2]) + (st1[0] + st1[2]), q = (st0[1] + st0[3]) + (st1[1] + st1[3]);
              sm += __shfl_xor(sm, 1); q += __shfl_xor(q, 1); sm += __shfl_xor(sm, 2); q += __shfl_xor(q, 2);
              const float mean = sm * (1.0f / AW), var = q * (1.0f / AW) - mean * mean;
              if ((tid & 3) == 0) { mr[(tid >> 2) * 2] = mean; mr[(tid >> 2) * 2 + 1] = 1.0f / sqrtf(fmaxf(var, 0.f) + EPS); } }
            __syncthreads();
#pragma unroll
            for (int i = 0; i < 4; ++i) { const int e = tid + i * NTHR, sr = e >> 4, c0 = (e & 15) * 8;
                f32x4 a, b; unpack8(gvr[i], a, b);
                const float mean = mr[sr * 2], rstd = mr[sr * 2 + 1];
                a = (a - mean) * rstd * lg0 + lb0; b = (b - mean) * rstd * lg1 + lb1;
                const u32x4 pw = pg8::pack8(a, b); const int rot = (e & 15);
#pragma unroll
                for (int j = 0; j < 8; ++j) { const int idx = (j + rot) & 7; *(LAS bf16_t*)(vnT + (c0 + idx) * (A_STRIDE * 2) + sr * 2) = pick16(pw, idx); } }
            if (un + G < (MP / CH) * NG) A_PREFETCH(un + G);
            __syncthreads();
            {
                const int n = lane & 15, quad = lane >> 4, t = wave * 16 + n; const int nks = (wave >> 1) + 1;
                const int row = row0 + t; const float bs = P.b_sp[g * CH + t];
                f32x4 acc[8];
#pragma unroll
                for (int ct = 0; ct < 8; ++ct) acc[ct] = (f32x4){0.f, 0.f, 0.f, 0.f};
#pragma unroll 1
                for (int ks = 0; ks < nks; ++ks) {
                    const bf16x8 wf = *(const LAS bf16x8*)(Wl + t * (A_STRIDE * 2) + (ks * 32 + quad * 8) * 2);
#pragma unroll
                    for (int ct = 0; ct < 8; ++ct) { const int c = ct * 16 + n; const bf16x8 vf = *(const LAS bf16x8*)(vnT + c * (A_STRIDE * 2) + (ks * 32 + quad * 8) * 2);
                        acc[ct] = __builtin_amdgcn_mfma_f32_16x16x32_bf16(vf, wf, acc[ct], 0, 0, 0); }
                }
#pragma unroll
                for (int ct = 0; ct < 8; ++ct) { const int col = g * CH + ct * 16 + quad * 4;
                    const f32x4 uu = {pg8::bf_lo(uw[ct].x), pg8::bf_hi(uw[ct].x), pg8::bf_lo(uw[ct].y), pg8::bf_hi(uw[ct].y)};
                    const f32x4 r = uu * (acc[ct] + bs); u32x2 w; w.x = pk2(r[0], r[1]); w.y = pk2(r[2], r[3]);
                    *(u32x2*)(AB + (size_t)row * 2048 + col) = w; }
            }
            __syncthreads();
        }
#undef A_PREFETCH
    }
    {
        LAS float* mr = (LAS float*)lds;
        for (int db = vcu; db < DB; db += G) {
            const int row0 = MP + db * DS;
            if (tid < DS) {
                const f32x4* sp = (const f32x4*)(stats + (size_t)(row0 + tid) * 32); float s = 0.f, q = 0.f;
#pragma unroll
                for (int j = 0; j < 8; ++j) { const f32x4 v = sp[j]; s += v[0] + v[2]; q += v[1] + v[3]; }
                const float mean = s * (1.0f / AW), var = q * (1.0f / AW) - mean * mean;
                mr[tid * 2] = mean; mr[tid * 2 + 1] = 1.0f / sqrtf(fmaxf(var, 0.f) + EPS);
            }
            __syncthreads();
            const int c = tid * 2, g = c >> 7;
            const f32x2 lg = *(const f32x2*)(P.ln_g + c), lb = *(const f32x2*)(P.ln_b + c);
            f32x2 vn[DS];
#pragma unroll
            for (int s = 0; s < DS; ++s) { const unsigned w = *(const unsigned*)(Z1 + (size_t)(row0 + s) * Z1W + C_V + c);
                const float mean = mr[s * 2], rstd = mr[s * 2 + 1];
                vn[s] = (f32x2){(pg8::bf_lo(w) - mean) * rstd * lg.x + lb.x, (pg8::bf_hi(w) - mean) * rstd * lg.y + lb.y};
                *(f32x2*)(P.out + O_CV + (size_t)(db * DS + s) * AW + c) = vn[s]; }
#pragma unroll
            for (int t = 0; t < DS; ++t) {
                const float bs = P.b_sp[g * CH + t]; f32x2 acc = {bs, bs};
#pragma unroll
                for (int s = 0; s <= t; ++s) { const float w = P.w_sp[((size_t)g * CH + t) * CH + s]; acc += vn[s] * w; }
                const unsigned uw = *(const unsigned*)(Z1 + (size_t)(row0 + t) * Z1W + C_U + c);
                *(unsigned*)(AB + (size_t)(row0 + t) * 2048 + c) = pk2(pg8::bf_lo(uw) * acc.x, pg8::bf_hi(uw) * acc.y);
            }
            __syncthreads();
        }
    }
    LAS unsigned char* Ks = lds; LAS unsigned char* VTs = lds + 256 * KS_STRIDE * 2;
    {
        u32x4 kr[4], vr[4];
#define B_PREFETCH(UN) do { const int blk_ = (UN) & 15, kvh_ = ((UN) >> 4) & 3, b_ = (UN) >> 6; const int krow0_ = b_ * SEQ + (blk_ - 1) * WIN; \
            _Pragma("unroll") for (int i = 0; i < 4; ++i) { const int e = tid + i * NTHR, key = e >> 3, c8 = (e & 7) * 8; \
                if (!(blk_ == 0 && key < WIN)) { const size_t zr = (size_t)(krow0_ + key) * Z1W; kr[i] = *(const u32x4*)(Z1 + zr + C_K + kvh_ * HD + c8); vr[i] = *(const u32x4*)(Z1 + zr + C_VA + kvh_ * HD + c8); } } } while (0)
        int un = vcu;
        if (un < NB * NKV * (SEQ / WIN)) B_PREFETCH(un);
        for (; un < NB * NKV * (SEQ / WIN); un += G) {
            const int blk = un & 15, kvh = (un >> 4) & 3, b = un >> 6; const bool first = blk == 0;
#pragma unroll
            for (int i = 0; i < 4; ++i) { const int e = tid + i * NTHR, key = e >> 3, c8 = (e & 7) * 8;
                const bool dead = first && key < WIN;
                const u32x4 kw = dead ? (u32x4){0u, 0u, 0u, 0u} : kr[i]; const u32x4 vw = dead ? (u32x4){0u, 0u, 0u, 0u} : vr[i];
                *(LAS u32x4*)(Ks + key * (KS_STRIDE * 2) + c8 * 2) = kw;
#pragma unroll
                for (int j = 0; j < 8; ++j) { const int idx = (j + (e & 7)) & 7; *(LAS bf16_t*)(VTs + (c8 + idx) * (VT_STRIDE * 2) + key * 2) = pick16(vw, idx); }
            }
            if (un + G < NB * NKV * (SEQ / WIN)) B_PREFETCH(un + G);
            __syncthreads();
            {
                const int head = kvh * 4 + (wave >> 1); const float sink2 = P.sinks[head] * LOG2E;
                const int rowb = b * SEQ + blk * WIN + (wave & 1) * 64 + (lane & 15);
                const bf16_t* qb = Z1 + (size_t)rowb * Z1W + C_Q + head * HD; const bf16_t* zb = Z1 + (size_t)rowb * Z1W + C_ZB + head * HD;
                const int quad_ = lane >> 4;
                QTile2In cur;
#pragma unroll
                for (int T = 0; T < 2; ++T) { const bf16_t* qn = qb + (size_t)T * 16 * Z1W; cur.qf[T][0] = *(const bf16x8*)(qn + quad_ * 8); cur.qf[T][1] = *(const bf16x8*)(qn + 32 + quad_ * 8); }
#pragma unroll 1
                for (int h2 = 0; h2 < 2; ++h2) {
#pragma unroll
                    for (int T = 0; T < 2; ++T)
#pragma unroll
                        for (int dt = 0; dt < 4; ++dt) cur.zw[T][dt] = *(const u32x2*)(zb + (size_t)(h2 * 2 + T) * 16 * Z1W + dt * 16 + quad_ * 4);
                    QTile2In use = cur;
                    if (h2 == 0) {
#pragma unroll
                        for (int T = 0; T < 2; ++T) { const bf16_t* qn = qb + (size_t)(2 + T) * 16 * Z1W; cur.qf[T][0] = *(const bf16x8*)(qn + quad_ * 8); cur.qf[T][1] = *(const bf16x8*)(qn + 32 + quad_ * 8); } }
                    attn_qtile2(use, Ks, VTs, lane, (wave & 1) * 4 + h2 * 2, first, sink2, AB + (size_t)(rowb + h2 * 32) * 2048 + AW + head * HD);
                }
            }
            __syncthreads();
        }
#undef B_PREFETCH
    }
    f32x4 ckr[4], cvr[4];
#define S_PREFETCH(UN) do { const int kvh_ = (UN) & 3, db_ = (UN) >> 2; \
        _Pragma("unroll") for (int i = 0; i < 4; ++i) { const int e = tid + i * NTHR; const size_t src = ((size_t)(db_ * WIN + (e >> 4)) * NKV + kvh_) * HD + (e & 15) * 4; \
            ckr[i] = *(const f32x4*)(P.ck + src); cvr[i] = *(const f32x4*)(P.cv + src); } } while (0)
    if (vcu < DB * NKV) S_PREFETCH(vcu);
    for (int un = vcu; un < DB * NKV; un += G) {
        const int kvh = un & 3, db = un >> 2; const int row0 = MP + db * DS;
        QTileIn qin;
        const int n_ = lane & 15; const int head_ = kvh * 4 + (wave & 1) * 2 + (n_ >> 3); const int row_ = row0 + (n_ & 7);
        if (wave < 2) qin = qtile_load(Z1 + (size_t)row_ * Z1W + C_Q + head_ * HD, Z1 + (size_t)row_ * Z1W + C_ZB + head_ * HD, lane);
#pragma unroll
        for (int i = 0; i < 4; ++i) { const int e = tid + i * NTHR, key = e >> 4, d0 = (e & 15) * 4;
            const f32x4 kv = ckr[i]; const f32x4 vv = cvr[i];
            const int i0 = d0 & 31, eo = d0 >> 5;
#pragma unroll
            for (int j = 0; j < 4; ++j) { *(LAS bf16_t*)(Ks + key * (KS_STRIDE * 2) + (2 * (i0 + j) + eo) * 2) = (bf16_t)f2bf(kv[j]);
                                          *(LAS bf16_t*)(VTs + (d0 + j) * (VT_STRIDE * 2) + key * 2) = (bf16_t)f2bf(vv[j]); } }
        if (un + G < DB * NKV) S_PREFETCH(un + G);
        if (tid < 32 * 8) { const int key = 128 + (tid >> 3), c8 = (tid & 7) * 8; u32x4 kw = {0u, 0u, 0u, 0u}, vw = {0u, 0u, 0u, 0u};
            if (key < 128 + DS) { const size_t zr = (size_t)(row0 + key - 128) * Z1W; kw = *(const u32x4*)(Z1 + zr + C_K + kvh * HD + c8); vw = *(const u32x4*)(Z1 + zr + C_VA + kvh * HD + c8); }
            *(LAS u32x4*)(Ks + key * (KS_STRIDE * 2) + c8 * 2) = kw;
            LAS unsigned char* vt = VTs + c8 * (VT_STRIDE * 2) + key * 2;
            *(LAS bf16_t*)(vt + 0 * VT_STRIDE * 2) = (bf16_t)(vw.x & 0xffff); *(LAS bf16_t*)(vt + 1 * VT_STRIDE * 2) = (bf16_t)(vw.x >> 16);
            *(LAS bf16_t*)(vt + 2 * VT_STRIDE * 2) = (bf16_t)(vw.y & 0xffff); *(LAS bf16_t*)(vt + 3 * VT_STRIDE * 2) = (bf16_t)(vw.y >> 16);
            *(LAS bf16_t*)(vt + 4 * VT_STRIDE * 2) = (bf16_t)(vw.z & 0xffff); *(LAS bf16_t*)(vt + 5 * VT_STRIDE * 2) = (bf16_t)(vw.z >> 16);
            *(LAS bf16_t*)(vt + 6 * VT_STRIDE * 2) = (bf16_t)(vw.w & 0xffff); *(LAS bf16_t*)(vt + 7 * VT_STRIDE * 2) = (bf16_t)(vw.w >> 16);
        }
        __syncthreads();
        if (wave < 2) attn_qtile<10, 1>(qin, Ks, VTs, lane, 0, false, P.sinks[head_] * LOG2E, AB + (size_t)row_ * 2048 + AW + head_ * HD);
        __syncthreads();
    }
#undef S_PREFETCH
}

__device__ __forceinline__ void stagger_wait(int ticks) {
    if (ticks > 0) { const unsigned long long t0 = __builtin_amdgcn_s_memrealtime(); while ((long long)(__builtin_amdgcn_s_memrealtime() - t0) < (long long)ticks) __builtin_amdgcn_s_sleep(16); }
}
#ifndef STAG1
#define STAG1 500
#endif
#ifndef STAG3
#define STAG3 600
#endif
struct Args { Ptrs p; int ph_lo, ph_hi; };
typedef const __attribute__((address_space(4))) Args* KArgPtr;
__device__ __forceinline__ Ptrs load_ptrs() {
    KArgPtr ap = (KArgPtr)__builtin_amdgcn_kernarg_segment_ptr(); asm volatile("" : "+s"(ap));
    Ptrs P; P.xp = ap->p.xp; P.xs = ap->p.xs; P.ck = ap->p.ck; P.cv = ap->p.cv; P.g_pre = ap->p.g_pre; P.w_in = ap->p.w_in; P.ln_g = ap->p.ln_g; P.ln_b = ap->p.ln_b;
    P.w_sp = ap->p.w_sp; P.b_sp = ap->p.b_sp; P.sinks = ap->p.sinks; P.w_pa = ap->p.w_pa; P.w_pb = ap->p.w_pb; P.w_out = ap->p.w_out; P.g_post = ap->p.g_post; P.out = ap->p.out; P.ws = ap->p.ws;
    return P;
}
__global__ void __launch_bounds__(NTHR, 2) fwd_kernel(Args args) {
    extern __shared__ __attribute__((aligned(16))) unsigned char lds_raw[];
    LAS unsigned char* lds = (LAS unsigned char*)lds_raw;
    const int tid = threadIdx.x, lane = tid & 63, wave = __builtin_amdgcn_readfirstlane(tid >> 6);
    const int G = gridDim.x, bx = blockIdx.x; int vcu = (G % 8 == 0) ? (bx % 8) * (G / 8) + bx / 8 : bx;
    const int lo = args.ph_lo, hi = args.ph_hi;
#ifndef PH_MASK
#define PH_MASK 63
#endif
#define IN(k) (((PH_MASK >> (k)) & 1) && lo <= (k) && (k) < hi)
#ifndef DUP_MASK
#define DUP_MASK 0
#endif
#define REP(k) for (int rep_ = 0; rep_ < (((DUP_MASK >> (k)) & 1) ? 2 : 1); ++rep_)
#define SEAM(k) do { if (IN(k) && IN((k) + 1)) xcd_barrier(bar); } while (0)
    if (lo == -12345) cg::this_grid().sync();
    volatile LAS unsigned* st = (volatile LAS unsigned*)(lds + 131072 + 64);
    if (tid < 3) st[tid] = 0u;
    __syncthreads();
    XcdBarrier bar; bar.bar = nullptr; bar.x = 0; bar.st = nullptr;
    if (hi - lo > 1) { KArgPtr ap0 = (KArgPtr)__builtin_amdgcn_kernarg_segment_ptr(); bar = xcd_barrier_post((unsigned*)(ap0->p.ws + WS_CTL), st); }
    __syncthreads();
    if (hi - lo > 1 && G == 256) { const unsigned rk = st[2]; if (bar.x < 8u && rk < 32u) vcu = (int)(bar.x * 32u + rk); }
    vcu = __builtin_amdgcn_readfirstlane(vcu);
    if (IN(0)) REP(0) { const Ptrs P = load_ptrs(); p0_prologue<0>(P, lds, vcu, G, wave, lane, tid); __syncthreads(); }
    SEAM(0);
    if (IN(1)) REP(1) {
        const Ptrs P = load_ptrs();
        bf16_t* WinT = (bf16_t*)(P.ws + WS_WIN); bf16_t* H = (bf16_t*)(P.ws + WS_H);
        pg8::StaticOrder S; S.init(M, INC, G, bx, 1); S.A0 = H; S.A1 = H; S.Bt0 = WinT; S.Bt1 = WinT; S.ntile = DM / 64;
        EpiIn E{(bf16_t*)(P.ws + WS_Z1), (bf16_t*)(P.ws + WS_G), (float*)(P.ws + WS_STATS), (const float*)(P.ws + WS_ROPE), P.out};
        pg8::gemm_phase<EpiIn, pg8::StaticOrder, true, true>(lds, S, E);
        { constexpr int NBIG = (M / 256) * (INC / 256) - 10 * 256;
          if (G == 256 && bx >= NBIG) p0_prologue<1>(P, lds, bx - NBIG, G - NBIG, wave, lane, tid); else if (G != 256) p0_prologue<1>(P, lds, vcu, G, wave, lane, tid); }
    }
    SEAM(1);
    if (IN(2)) REP(2) { const Ptrs P = load_ptrs(); p2_mixers(P, lds, vcu, G, wave, lane, tid); }
    SEAM(2);
    if (IN(3)) {
        const Ptrs P = load_ptrs();
        unsigned* ctr = (unsigned*)(P.ws + WS_SSQ);
        MOOrder S; S.c = vcu; S.AB = (const bf16_t*)(P.ws + WS_H); S.WpT = (const bf16_t*)(P.ws + WS_WP); S.MG = (const bf16_t*)(P.ws + WS_Z1); S.WoutT = (const bf16_t*)(P.ws + WS_WOUT); S.mgcnt = ctr + 2 * M;
        EpiMO E{EpiMerge{(const bf16_t*)(P.ws + WS_G), (bf16_t*)(P.ws + WS_Z1), ctr + 2 * M}, EpiOutNorm{P.xp, P.xs, P.g_post, P.out + O_Y, ctr}};
        pg8::gemm_phase<EpiMO, MOOrder, true, true>(lds, S, E);
    }
#undef IN
#undef SEAM
}

extern "C" void kernel_launch(void* const* d_in, const int* in_sizes, int n_in, void* d_out, int out_size, void* d_ws, size_t ws_size, hipStream_t stream) {
    static int grid = 0;
    if (grid == 0) {
        if (n_in != 15 || in_sizes[0] != MP * DM || (size_t)out_size != O_END || ws_size < WS_END) {
            fprintf(stderr, "kernel_launch: unexpected shapes (n_in %d, in0 %d, out %d, ws %zu, need %zu)\n", n_in, n_in > 0 ? in_sizes[0] : -1, out_size, ws_size, (size_t)WS_END); grid = -1; return; }
        if (hipFuncSetAttribute((const void*)fwd_kernel, hipFuncAttributeMaxDynamicSharedMemorySize, LDS_BYTES) != hipSuccess) { fprintf(stderr, "kernel_launch: hipFuncSetAttribute failed\n"); grid = -1; return; }
        int dev = 0, cus = 0, per_cu = 0;
        hipGetDevice(&dev); hipDeviceGetAttribute(&cus, hipDeviceAttributeMultiprocessorCount, dev);
        hipOccupancyMaxActiveBlocksPerMultiprocessor(&per_cu, (const void*)fwd_kernel, NTHR, LDS_BYTES);
        if (per_cu < 1) { fprintf(stderr, "kernel_launch: occupancy query says %d blocks per CU\n", per_cu); per_cu = 1; }
        (void)hipGetLastError();
        grid = cus;
    }
    if (grid < 0) return;
    if (hipMemsetAsync((char*)d_ws + WS_CTL, 0, CTL_ZERO_BYTES, stream) != hipSuccess) { fprintf(stderr, "kernel_launch: hipMemsetAsync failed\n"); return; }
    Args a{};
    a.p.xp = (const float*)d_in[0]; a.p.xs = (const float*)d_in[1]; a.p.ck = (const float*)d_in[2]; a.p.cv = (const float*)d_in[3]; a.p.g_pre = (const float*)d_in[4];
    a.p.w_in = (const float*)d_in[5]; a.p.ln_g = (const float*)d_in[6]; a.p.ln_b = (const float*)d_in[7]; a.p.w_sp = (const float*)d_in[8]; a.p.b_sp = (const float*)d_in[9];
    a.p.sinks = (const float*)d_in[10]; a.p.w_pa = (const float*)d_in[11]; a.p.w_pb = (const float*)d_in[12]; a.p.w_out = (const float*)d_in[13]; a.p.g_post = (const float*)d_in[14];
    a.p.out = (float*)d_out; a.p.ws = (unsigned char*)d_ws;
#if MK_N_LAUNCHES == 1
    a.ph_lo = 0; a.ph_hi = 4;
    void* kargs[] = {&a};
    hipError_t e = hipLaunchCooperativeKernel((const void*)fwd_kernel, dim3(grid), dim3(NTHR), kargs, LDS_BYTES, stream);
    if (e != hipSuccess) fprintf(stderr, "kernel_launch: cooperative launch failed: %s (grid %d)\n", hipGetErrorString(e), grid);
#else
    for (int ph = 0; ph < 4; ++ph) { a.ph_lo = ph; a.ph_hi = ph + 1; hipLaunchKernelGGL(fwd_kernel, dim3(grid), dim3(NTHR), LDS_BYTES, stream, a); }
#endif
}
```
